# Optimizing an MI355X kernel written in HIP

```python
import jax, jax.numpy as jnp
from jax import lax
import numpy as np

D_MODEL = 1024
BATCH = 8
SEQ = 4096
DEPTH = 1

MIX_WIDTH = D_MODEL
C_CONV = MIX_WIDTH // 2
CONV_HEADS = 8
C_POOL = MIX_WIDTH - C_CONV
POOL_WINDOWS = (2, 4, 8, 16)
N_POOL_GROUPS = len(POOL_WINDOWS)
POOL_GROUP = C_POOL // N_POOL_GROUPS
CONV_K = 31
D_FF = ((8 * D_MODEL // 3 + 255) // 256) * 256
D_PLE = 256
EPS = 1e-6

kernel_name = "hybrid_conformer_conv_multiscale_pool_block"


def rmsnorm(x, g):
    xf = x.astype(jnp.float32)
    y = xf * lax.rsqrt(jnp.mean(xf * xf, axis=-1, keepdims=True) + EPS)
    return (y * g.astype(jnp.float32)).astype(x.dtype)


def layernorm(x, g, b):
    xf = x.astype(jnp.float32)
    mu = jnp.mean(xf, axis=-1, keepdims=True)
    var = jnp.mean(jnp.square(xf - mu), axis=-1, keepdims=True)
    y = (xf - mu) * lax.rsqrt(var + EPS)
    return (y * g.astype(jnp.float32) + b.astype(jnp.float32)).astype(x.dtype)


def causal_depthwise_conv(u, w, b):
    c = u.shape[-1]
    k = w.reshape(CONV_K, 1, c).astype(u.dtype)
    y = lax.conv_general_dilated(
        u, k, window_strides=(1,), padding=[(CONV_K - 1, 0)],
        dimension_numbers=("NWC", "WIO", "NWC"), feature_group_count=c)
    return y + b.astype(u.dtype)


def multiscale_pool(v, pool_w, pool_scale):
    s = v.shape[1]
    vf = v.astype(jnp.float32)
    groups = vf.reshape(vf.shape[0], s, N_POOL_GROUPS, POOL_GROUP)
    pos1 = jnp.arange(1, s + 1, dtype=jnp.float32)[None, :, None]
    outs = []
    for g, w in enumerate(POOL_WINDOWS):
        vg = groups[:, :, g, :]
        c = jnp.cumsum(vg, axis=1)
        c_shift = jnp.pad(c, ((0, 0), (w, 0), (0, 0)))[:, :s]
        cnt = jnp.minimum(pos1, float(w))
        outs.append((c - c_shift) / cnt - vg)
    pooled = jnp.stack(outs, axis=2)
    mixed = jnp.einsum("bsgc,gcd->bsgd", pooled, pool_w.astype(jnp.float32))
    mixed = mixed.reshape(vf.shape) * pool_scale.astype(jnp.float32)
    return mixed.astype(v.dtype)


def setup_inputs(seed: int = 0) -> dict:
    key = jax.random.key(seed)
    ks = jax.random.split(key, 20)
    L, D = DEPTH, D_MODEL
    n = lambda k, shape, fan: jax.random.normal(k, shape, jnp.float32) * (fan ** -0.5)
    gain = lambda k, shape: 1.0 + 0.05 * jax.random.normal(k, shape, jnp.float32)
    return {
        "x": jax.random.normal(ks[0], (BATCH, SEQ, D), jnp.float32),
        "p": jax.random.normal(ks[1], (DEPTH, BATCH, SEQ, D_PLE), jnp.float32),
        "g_mix": gain(ks[2], (L, D)),
        "w_in": n(ks[3], (L, D, 2 * C_CONV + C_POOL), D),
        "conv_w": n(ks[4], (L, CONV_K, C_CONV), CONV_K),
        "conv_b": 0.02 * jax.random.normal(ks[5], (L, C_CONV), jnp.float32),
        "ln_g": gain(ks[6], (L, C_CONV)),
        "ln_b": 0.02 * jax.random.normal(ks[7], (L, C_CONV), jnp.float32),
        "pool_w": n(ks[8], (L, N_POOL_GROUPS, POOL_GROUP, POOL_GROUP), POOL_GROUP),
        "pool_scale": gain(ks[9], (L, C_POOL)),
        "w_out": n(ks[10], (L, MIX_WIDTH, D), MIX_WIDTH),
        "g_ffn": gain(ks[11], (L, D)),
        "w_gate_up": n(ks[12], (L, D, 2 * D_FF), D),
        "w_down": n(ks[13], (L, D_FF, D), D_FF),
        "g_ple_gate": gain(ks[14], (L, D)),
        "w_ple_gate": n(ks[15], (L, D, D), D),
        "w_ple_up": n(ks[16], (L, D_PLE, D), D_PLE),
        "g_ple_post": gain(ks[17], (L, D)),
        "g_final": gain(ks[18], (D,)),
    }


def reference(x, p, g_mix, w_in, conv_w, conv_b, ln_g, ln_b, pool_w, pool_scale,
              w_out, g_ffn, w_gate_up, w_down, g_ple_gate, w_ple_gate, w_ple_up,
              g_ple_post, g_final):
    for i in range(DEPTH):
        h = rmsnorm(x, g_mix[i])
        z = h @ w_in[i]
        a = z[..., :C_CONV]
        b = z[..., C_CONV:2 * C_CONV]
        v = z[..., 2 * C_CONV:]
        u = a * jax.nn.sigmoid(b)
        u = causal_depthwise_conv(u, conv_w[i], conv_b[i])
        u = jax.nn.silu(layernorm(u, ln_g[i], ln_b[i]))
        q = multiscale_pool(v, pool_w[i], pool_scale[i])
        mix = jnp.concatenate([u, q], axis=-1)
        x = x + mix @ w_out[i]
        h = rmsnorm(x, g_ffn[i])
        gu = h @ w_gate_up[i]
        x = x + (jax.nn.silu(gu[..., :D_FF]) * gu[..., D_FF:]) @ w_down[i]
        gate = jax.nn.sigmoid(rmsnorm(x, g_ple_gate[i]) @ w_ple_gate[i])
        e = rmsnorm(p[i].astype(x.dtype) @ w_ple_up[i], g_ple_post[i])
        x = x + gate * e
    return rmsnorm(x, g_final)
```

```cpp
#include <hip/hip_runtime.h>
#include <hip/hip_cooperative_groups.h>
#include <cstdio>
#include <cstdint>
namespace cg = cooperative_groups;
namespace pg8 {
#define PG8_LAS __attribute__((address_space(3)))
typedef unsigned short bf16_t;
typedef short bf16x8 __attribute__((ext_vector_type(8)));
typedef float f32x4 __attribute__((ext_vector_type(4)));
typedef unsigned u32x4 __attribute__((ext_vector_type(4)));
constexpr int BM = 256, BK = 64, HALF = 128, HTB = HALF * BK * 2  , STAGE_BYTES = 8 * HTB, NXCD = 8, WGM = 8;

__host__ __device__ __forceinline__ int lds_byte(int r, int c) { const int st = (r >> 4) * 2 + (c >> 5), rr = r & 15, cc = c & 31, ob = rr * 64 + cc * 2; return st * 1024 + (ob ^ (((ob >> 9) & 1) << 5)); }
__host__ __device__ __forceinline__ void stage_rc(int b, int& R, int& C) { const int st = b / 1024, sb = b % 1024, swz = sb ^ (((sb >> 9) & 1) << 5); R = (st >> 1) * 16 + swz / 64; C = (st & 1) * 32 + (swz % 64) / 2; }
__host__ __device__ __forceinline__ int perm32(int rho) { const int n = rho >> 4, i = rho & 15; return 8 * (i >> 2) + 4 * n + (i & 3); }

struct Unit { int pm, pn; };
struct Gemm { const bf16_t* A; const bf16_t* Bt; int M, N, K; };

struct StaticOrder {
    int nM, nN, nwg, G, c;
    __host__ __device__ void init(int M, int N, int G_, int c_) { nM = M / BM; nN = N / BM; nwg = nM * nN; G = G_; c = c_; }
    __host__ __device__ bool next(int i, Unit& u) const {
        const long L = (long)i * G + c; if (L >= nwg) return false;
        int wgid = (int)L; { const int q = nwg / NXCD, r = nwg % NXCD, xcd = wgid % NXCD, off = wgid / NXCD; wgid = (xcd < r ? xcd * (q + 1) : r * (q + 1) + (xcd - r) * q) + off; }
        const int nig = WGM * nN, gid = wgid / nig, fm = gid * WGM, gsz = (nM - fm) < WGM ? (nM - fm) : WGM;
        u.pm = fm + ((wgid % nig) % gsz); u.pn = (wgid % nig) / gsz; return true;
    }
    __device__ __forceinline__ void a_ready(const Unit&) const {}
    __device__ __forceinline__ void done(const Unit&) const {}
};

__device__ __forceinline__ unsigned cvt_pk_bf16(float lo, float hi) { unsigned r; asm volatile("v_cvt_pk_bf16_f32 %0, %1, %2" : "=v"(r) : "v"(lo), "v"(hi)); return r; }
typedef float f32x2 __attribute__((ext_vector_type(2)));
constexpr float RMS_EPS = 1e-6f;
__device__ __forceinline__ float sigm(float x) { return __builtin_amdgcn_rcpf(1.0f + __builtin_amdgcn_exp2f(-1.4426950408889634f * x)); }
__device__ __forceinline__ u32x4 pack8(const f32x4 a, const f32x4 b) { u32x4 w; w.x = cvt_pk_bf16(a[0], a[1]); w.y = cvt_pk_bf16(a[2], a[3]); w.z = cvt_pk_bf16(b[0], b[1]); w.w = cvt_pk_bf16(b[2], b[3]); return w; }
__device__ __forceinline__ float bf_lo(unsigned w) { return __uint_as_float(w << 16); }
__device__ __forceinline__ float bf_hi(unsigned w) { return __uint_as_float(w & 0xffff0000u); }
__device__ __forceinline__ float row_rstd(const float* ssq, int r, int fq) {
    const f32x4 p = *(const f32x4*)(ssq + (size_t)r * 16 + 4 * fq);
    float s = (p[0] + p[1]) + (p[2] + p[3]); s += __shfl_xor(s, 16); s += __shfl_xor(s, 32);
    return rsqrtf(s * (1.0f / 1024.0f) + RMS_EPS);
}

struct EpiGlu {
    static constexpr bool PERM = true, AFTER_DRAIN = false;
    bf16_t* UV;
    __device__ __forceinline__ void operator()(const f32x4 (&acc)[2][2][4][2], const Unit& u, int wr, int wc, int fr, int fq) const {
        const int row0 = u.pm * BM + wr * 64 + fr;
        if (u.pn < 4) {
            const int col0 = u.pn * 128 + wc * 32 + 8 * fq;
#pragma unroll
            for (int ai = 0; ai < 2; ++ai)
#pragma unroll
                for (int m = 0; m < 4; ++m) {
                    f32x4 o[2];
#pragma unroll
                    for (int n = 0; n < 2; ++n)
#pragma unroll
                        for (int i = 0; i < 4; ++i) o[n][i] = acc[ai][0][m][n][i] * sigm(acc[ai][1][m][n][i]);
                    *(u32x4*)(UV + (size_t)(row0 + ai * HALF + m * 16) * 1024 + col0) = pack8(o[0], o[1]);
                }
        } else {
            const int col0 = 512 + (u.pn - 4) * 256 + wc * 32 + 8 * fq;
#pragma unroll
            for (int ai = 0; ai < 2; ++ai)
#pragma unroll
                for (int m = 0; m < 4; ++m)
#pragma unroll
                    for (int bj = 0; bj < 2; ++bj)
                        *(u32x4*)(UV + (size_t)(row0 + ai * HALF + m * 16) * 1024 + col0 + bj * HALF) = pack8(acc[ai][bj][m][0], acc[ai][bj][m][1]);
        }
    }
};

struct EpiSwiglu {
    static constexpr bool PERM = true, AFTER_DRAIN = false;
    bf16_t* ACT; int ldc; const float* ssq;
    __device__ __forceinline__ void operator()(const f32x4 (&acc)[2][2][4][2], const Unit& u, int wr, int wc, int fr, int fq) const {
        const int row0 = u.pm * BM + wr * 64 + fr, col0 = u.pn * 128 + wc * 32 + 8 * fq;
        float rs[2][4];
#pragma unroll
        for (int ai = 0; ai < 2; ++ai)
#pragma unroll
            for (int m = 0; m < 4; ++m) rs[ai][m] = row_rstd(ssq, row0 + ai * HALF + m * 16, fq);
#pragma unroll
        for (int ai = 0; ai < 2; ++ai)
#pragma unroll
            for (int m = 0; m < 4; ++m) {
                f32x4 o[2]; const float r = rs[ai][m];
#pragma unroll
                for (int n = 0; n < 2; ++n)
#pragma unroll
                    for (int i = 0; i < 4; ++i) { const float g = acc[ai][0][m][n][i] * r, up = acc[ai][1][m][n][i] * r; o[n][i] = g * sigm(g) * up; }
                *(u32x4*)(ACT + (size_t)(row0 + ai * HALF + m * 16) * ldc + col0) = pack8(o[0], o[1]);
            }
    }
};

struct EpiRes {
    static constexpr bool PERM = true, AFTER_DRAIN = false;
    const float* base; float* out32; bf16_t* outb; float* ssq;
    __device__ __forceinline__ void operator()(const f32x4 (&acc)[2][2][4][2], const Unit& u, int wr, int wc, int fr, int fq) const {
        const int row0 = u.pm * BM + wr * 64 + fr, col0 = u.pn * BM + wc * 32 + 8 * fq;
#pragma unroll
        for (int ai = 0; ai < 2; ++ai)
#pragma unroll
            for (int m = 0; m < 4; ++m) {
                const int r = row0 + ai * HALF + m * 16; float q = 0.f;
#pragma unroll
                for (int bj = 0; bj < 2; ++bj) {
                    const size_t off = (size_t)r * 1024 + col0 + bj * HALF;
                    const f32x4 v0 = *(const f32x4*)(base + off) + acc[ai][bj][m][0], v1 = *(const f32x4*)(base + off + 4) + acc[ai][bj][m][1];
                    *(f32x4*)(out32 + off) = v0; *(f32x4*)(out32 + off + 4) = v1;
                    *(u32x4*)(outb + off) = pack8(v0, v1);
                    q += (v0[0] * v0[0] + v0[1] * v0[1]) + (v0[2] * v0[2] + v0[3] * v0[3]) + (v1[0] * v1[0] + v1[1] * v1[1]) + (v1[2] * v1[2] + v1[3] * v1[3]);
                }
                q += __shfl_xor(q, 16); q += __shfl_xor(q, 32);
                if (fq == 0) ssq[(size_t)r * 16 + u.pn * 4 + wc] = q;
            }
    }
};

struct EpiRaw {
    static constexpr bool PERM = true, AFTER_DRAIN = false;
    bf16_t* outb; float* ssq;
    __device__ __forceinline__ void operator()(const f32x4 (&acc)[2][2][4][2], const Unit& u, int wr, int wc, int fr, int fq) const {
        const int row0 = u.pm * BM + wr * 64 + fr, col0 = u.pn * BM + wc * 32 + 8 * fq;
#pragma unroll
        for (int ai = 0; ai < 2; ++ai)
#pragma unroll
            for (int m = 0; m < 4; ++m) {
                const int r = row0 + ai * HALF + m * 16; float q = 0.f;
#pragma unroll
                for (int bj = 0; bj < 2; ++bj) {
                    const size_t off = (size_t)r * 1024 + col0 + bj * HALF;
                    const f32x4 v0 = acc[ai][bj][m][0], v1 = acc[ai][bj][m][1];
                    *(u32x4*)(outb + off) = pack8(v0, v1);
                    q += (v0[0] * v0[0] + v0[1] * v0[1]) + (v0[2] * v0[2] + v0[3] * v0[3]) + (v1[0] * v1[0] + v1[1] * v1[1]) + (v1[2] * v1[2] + v1[3] * v1[3]);
                }
                q += __shfl_xor(q, 16); q += __shfl_xor(q, 32);
                if (fq == 0) ssq[(size_t)r * 16 + u.pn * 4 + wc] = q;
            }
    }
};

struct EpiPle {
    static constexpr bool PERM = true, AFTER_DRAIN = false;
    float* xio; const bf16_t* eraw; const float* ssq3; const float* ssqe; const float* gpost;
    __device__ __forceinline__ void operator()(const f32x4 (&acc)[2][2][4][2], const Unit& u, int wr, int wc, int fr, int fq) const {
        const int row0 = u.pm * BM + wr * 64 + fr, col0 = u.pn * BM + wc * 32 + 8 * fq;
        f32x4 gp[2][2];
#pragma unroll
        for (int bj = 0; bj < 2; ++bj)
#pragma unroll
            for (int n = 0; n < 2; ++n) gp[bj][n] = *(const f32x4*)(gpost + col0 + bj * HALF + 4 * n);
#pragma unroll
        for (int ai = 0; ai < 2; ++ai)
#pragma unroll
            for (int m = 0; m < 4; ++m) {
                const int r = row0 + ai * HALF + m * 16;
                const float r3 = row_rstd(ssq3, r, fq), re = row_rstd(ssqe, r, fq);
#pragma unroll
                for (int bj = 0; bj < 2; ++bj) {
                    const size_t off = (size_t)r * 1024 + col0 + bj * HALF;
                    const u32x4 ew = *(const u32x4*)(eraw + off);
                    f32x4 e0 = (f32x4){bf_lo(ew.x), bf_hi(ew.x), bf_lo(ew.y), bf_hi(ew.y)}, e1 = (f32x4){bf_lo(ew.z), bf_hi(ew.z), bf_lo(ew.w), bf_hi(ew.w)};
                    f32x4 x0 = *(const f32x4*)(xio + off), x1 = *(const f32x4*)(xio + off + 4);
#pragma unroll
                    for (int i = 0; i < 4; ++i) { x0[i] += sigm(acc[ai][bj][m][0][i] * r3) * (e0[i] * re * gp[bj][0][i]); x1[i] += sigm(acc[ai][bj][m][1][i] * r3) * (e1[i] * re * gp[bj][1][i]); }
                    *(f32x4*)(xio + off) = x0; *(f32x4*)(xio + off + 4) = x1;
                }
            }
    }
};

template <class Epi, class Sched, bool ALIGN_EPI = false, bool SP2 = false>
__device__ __forceinline__ void gemm_phase(PG8_LAS unsigned char* lds, const Gemm g, const Sched& S, const Epi& E) {
    const int tid = threadIdx.x, wid = __builtin_amdgcn_readfirstlane(tid >> 6), lane = tid & 63, wr = wid >> 2, wc = wid & 3, fr = lane & 15, fq = lane >> 4;
    const int K = g.K, nt = K / BK;
    unsigned voffA[2], voffB[2];
#pragma unroll
    for (int i = 0; i < 2; ++i) { int R, C; stage_rc(tid * 16 + i * 8192, R, C); const int Rb = Epi::PERM ? ((R & ~31) + perm32(R & 31)) : R;
        voffA[i] = (unsigned)(R * K + C) * 2u; voffB[i] = (unsigned)(Rb * K + C) * 2u; }
    const size_t kstep = (size_t)(BK * 2);
    const size_t hstep = (size_t)HALF * K * 2;
    const size_t tstep = 2 * hstep;
    const unsigned ldsw = (unsigned)wid * 1024u;
    const int aoff = lds_byte(wr * 64 + fr, fq * 8), boff = lds_byte(wc * 32 + fr, fq * 8);
#define PG8_SA(b, h) (((b) * 2 + (h)) * HTB)
#define PG8_SB(b, h) ((4 + (b) * 2 + (h)) * HTB)
#define PG8_STAGE(bufoff, gbase, voff) do { _Pragma("unroll") for (int _i = 0; _i < 2; ++_i) \
        __builtin_amdgcn_global_load_lds((const unsigned*)((const char*)(gbase) + (voff)[_i]), (PG8_LAS unsigned*)(lds + (bufoff) + ldsw + _i * 8192), 16, 0, 0); } while (0)
#define PG8_LDA(dst, b, h) do { _Pragma("unroll") for (int m = 0; m < 4; ++m) _Pragma("unroll") for (int k = 0; k < 2; ++k) dst[m][k] = *(const PG8_LAS bf16x8*)(lds + PG8_SA(b, h) + aoff + m * 2048 + k * 1024); } while (0)
#define PG8_LDB(dst, b, h) do { _Pragma("unroll") for (int n = 0; n < 2; ++n) _Pragma("unroll") for (int k = 0; k < 2; ++k) dst[n][k] = *(const PG8_LAS bf16x8*)(lds + PG8_SB(b, h) + boff + n * 2048 + k * 1024); } while (0)
#define PG8_MMA(ai, bj, At, Bt) do { __builtin_amdgcn_s_setprio(1); _Pragma("unroll") for (int m = 0; m < 4; ++m) _Pragma("unroll") for (int n = 0; n < 2; ++n) _Pragma("unroll") for (int k = 0; k < 2; ++k) \
        acc[ai][bj][m][n] = __builtin_amdgcn_mfma_f32_16x16x32_bf16(Bt[n][k], At[m][k], acc[ai][bj][m][n], 0, 0, 0); __builtin_amdgcn_s_setprio(0); } while (0)
#define PG8_WAIT_V(n) asm volatile("s_waitcnt vmcnt(" #n ")" ::: "memory")
#define PG8_WAIT_L(n) asm volatile("s_waitcnt lgkmcnt(" #n ")" ::: "memory")
#define PG8_BAR __builtin_amdgcn_s_barrier()
#define PG8_SCHED __builtin_amdgcn_sched_barrier(0)
    Unit cur, nxt; int ui = 0;
    if (!S.next(0, cur)) return;
    f32x4 acc[2][2][4][2];
#pragma unroll
    for (int a = 0; a < 2; ++a)
#pragma unroll
        for (int b = 0; b < 2; ++b)
#pragma unroll
            for (int m = 0; m < 4; ++m)
#pragma unroll
                for (int n = 0; n < 2; ++n) acc[a][b][m][n] = (f32x4){0.f, 0.f, 0.f, 0.f};
    bf16x8 At[4][2], B0[2][2], B1[2][2];
    const char* cA = (const char*)g.A + (size_t)cur.pm * tstep; const char* cB = (const char*)g.Bt + (size_t)cur.pn * tstep;
    S.a_ready(cur);
    if constexpr (SP2) {
        PG8_STAGE(PG8_SB(0, 0), cB, voffB); PG8_STAGE(PG8_SB(0, 1), cB + hstep, voffB); PG8_STAGE(PG8_SA(0, 0), cA, voffA); PG8_STAGE(PG8_SA(0, 1), cA + hstep, voffA);
        if (wr == 1) PG8_BAR;
        PG8_WAIT_V(2); PG8_BAR;
        PG8_STAGE(PG8_SB(1, 0), cB + kstep, voffB); PG8_STAGE(PG8_SA(1, 0), cA + kstep, voffA); PG8_STAGE(PG8_SB(1, 1), cB + hstep + kstep, voffB);
        PG8_WAIT_V(6); PG8_BAR;
    } else {
        PG8_STAGE(PG8_SB(0, 0), cB, voffB); PG8_STAGE(PG8_SA(0, 0), cA, voffA); PG8_STAGE(PG8_SB(0, 1), cB + hstep, voffB); PG8_STAGE(PG8_SA(0, 1), cA + hstep, voffA);
        if (wr == 1) PG8_BAR;
        PG8_WAIT_V(4); PG8_BAR;
        PG8_STAGE(PG8_SB(1, 0), cB + kstep, voffB); PG8_STAGE(PG8_SA(1, 0), cA + kstep, voffA); PG8_STAGE(PG8_SB(1, 1), cB + hstep + kstep, voffB);
        PG8_WAIT_V(6); PG8_BAR;
    }
    for (;;) {
        const bool has_next = S.next(ui + 1, nxt);
        const char* nA = has_next ? (const char*)g.A + (size_t)nxt.pm * tstep : cA; const char* nB = has_next ? (const char*)g.Bt + (size_t)nxt.pn * tstep : cB;
        for (int t = 0; t < nt; t += 2) {
            const bool last = (t == nt - 2);
            const char* a1 = cA + (size_t)(t + 1) * kstep;
            const char* a2 = last ? nA : cA + (size_t)(t + 2) * kstep; const char* b2 = last ? nB : cB + (size_t)(t + 2) * kstep;
            const char* a3 = a2 + kstep; const char* b3 = b2 + kstep;
            if (last && has_next) S.a_ready(nxt);
            if constexpr (SP2) {
            PG8_LDB(B0, 0, 0); PG8_LDB(B1, 0, 1); PG8_SCHED; PG8_LDA(At, 0, 0); PG8_STAGE(PG8_SA(1, 1), a1 + hstep, voffA);
            PG8_WAIT_V(8); PG8_WAIT_L(0); PG8_BAR; PG8_MMA(0, 0, At, B0); PG8_MMA(0, 1, At, B1); PG8_BAR; PG8_SCHED;
            PG8_LDA(At, 0, 1); PG8_STAGE(PG8_SB(0, 0), b2, voffB); PG8_STAGE(PG8_SB(0, 1), b2 + hstep, voffB); PG8_STAGE(PG8_SA(0, 0), a2, voffA);
            PG8_WAIT_V(8); PG8_WAIT_L(0); PG8_BAR; PG8_MMA(1, 0, At, B0); PG8_MMA(1, 1, At, B1); PG8_BAR; PG8_SCHED;
            PG8_LDB(B0, 1, 0); PG8_LDB(B1, 1, 1); PG8_SCHED; PG8_LDA(At, 1, 0); PG8_STAGE(PG8_SA(0, 1), a2 + hstep, voffA);
            PG8_WAIT_V(8); PG8_WAIT_L(0); PG8_BAR; PG8_MMA(0, 0, At, B0); PG8_MMA(0, 1, At, B1); PG8_BAR; PG8_SCHED;
            PG8_LDA(At, 1, 1); PG8_STAGE(PG8_SB(1, 0), b3, voffB); PG8_STAGE(PG8_SB(1, 1), b3 + hstep, voffB); PG8_STAGE(PG8_SA(1, 0), a3, voffA);
            PG8_WAIT_V(8); PG8_WAIT_L(0); PG8_BAR; PG8_MMA(1, 0, At, B0); PG8_MMA(1, 1, At, B1); PG8_BAR; PG8_SCHED;
            } else {
            PG8_LDB(B0, 0, 0); PG8_SCHED; PG8_LDA(At, 0, 0); PG8_STAGE(PG8_SA(1, 1), a1 + hstep, voffA);
            PG8_WAIT_L(8); PG8_BAR; PG8_WAIT_L(0); PG8_MMA(0, 0, At, B0); PG8_BAR; PG8_SCHED;
            PG8_LDB(B1, 0, 1); PG8_STAGE(PG8_SB(0, 0), b2, voffB);
            PG8_BAR; PG8_WAIT_L(0); PG8_MMA(0, 1, At, B1); PG8_BAR;
            PG8_LDA(At, 0, 1); PG8_STAGE(PG8_SA(0, 0), a2, voffA);
            PG8_BAR; PG8_WAIT_L(0); PG8_MMA(1, 0, At, B0); PG8_BAR; PG8_SCHED;
            PG8_STAGE(PG8_SB(0, 1), b2 + hstep, voffB);
            PG8_WAIT_V(6); PG8_BAR; PG8_MMA(1, 1, At, B1); PG8_BAR;
            PG8_LDB(B0, 1, 0); PG8_SCHED; PG8_LDA(At, 1, 0); PG8_STAGE(PG8_SA(0, 1), a2 + hstep, voffA);
            PG8_WAIT_L(8); PG8_BAR; PG8_WAIT_L(0); PG8_MMA(0, 0, At, B0); PG8_BAR; PG8_SCHED;
            PG8_LDB(B1, 1, 1); PG8_STAGE(PG8_SB(1, 0), b3, voffB);
            PG8_BAR; PG8_WAIT_L(0); PG8_MMA(0, 1, At, B1); PG8_BAR;
            PG8_LDA(At, 1, 1); PG8_STAGE(PG8_SA(1, 0), a3, voffA);
            PG8_BAR; PG8_WAIT_L(0); PG8_MMA(1, 0, At, B0); PG8_BAR; PG8_SCHED;
            PG8_STAGE(PG8_SB(1, 1), b3 + hstep, voffB);
            PG8_WAIT_V(6); PG8_BAR; PG8_MMA(1, 1, At, B1); PG8_BAR;
            }
        }
        if constexpr (ALIGN_EPI) { if (wr == 0) PG8_BAR; }
        if constexpr (!Epi::AFTER_DRAIN) { E(acc, cur, wr, wc, fr, fq); S.done(cur); }
        if (!has_next) break;
#pragma unroll
        for (int a = 0; a < 2; ++a)
#pragma unroll
            for (int b = 0; b < 2; ++b)
#pragma unroll
                for (int m = 0; m < 4; ++m)
#pragma unroll
                    for (int n = 0; n < 2; ++n) acc[a][b][m][n] = (f32x4){0.f, 0.f, 0.f, 0.f};
        cur = nxt; cA = nA; cB = nB; ++ui;
        if constexpr (ALIGN_EPI) { if (wr == 1) PG8_BAR; }
    }
    PG8_WAIT_V(0);
    if constexpr (!ALIGN_EPI) { if (wr == 0) PG8_BAR; }
    PG8_BAR;
    if constexpr (Epi::AFTER_DRAIN) { E.fused(acc, cur, wr, wc, fr, fq, lds, wid, lane); S.done(cur); }
#undef PG8_SA
#undef PG8_SB
#undef PG8_STAGE
#undef PG8_LDA
#undef PG8_LDB
#undef PG8_MMA
#undef PG8_WAIT_V
#undef PG8_WAIT_L
#undef PG8_BAR
#undef PG8_SCHED
}
}
#ifndef PG8_SP2
#define PG8_SP2 true
#endif
#ifndef PG8_ALIGN
#define PG8_ALIGN true
#endif
constexpr int NWAVES = 8;
#ifndef MK_N_LAUNCHES
#define MK_N_LAUNCHES 1
#endif
constexpr int N_PHASES = 9;
constexpr int N_LAUNCHES = MK_N_LAUNCHES;

constexpr int BATCH = 8, SEQ = 4096, D = 1024, M = BATCH * SEQ, NIN = 1536, CCONV = 512, FF = 2816, DPLE = 256, CONVK = 31;
constexpr float EPS = 1e-6f;
constexpr size_t MiB = 1u << 20;
constexpr size_t WS_WIN = 2 * MiB, WS_WOUT = 5 * MiB, WS_WGU = 7 * MiB, WS_WD = 18 * MiB, WS_WPG = 24 * MiB, WS_WPU = 26 * MiB;
constexpr size_t WS_SSQ2 = 30 * MiB, WS_SSQ3 = 32 * MiB, WS_SSQE = 34 * MiB;
constexpr size_t WS_PB = 40 * MiB;
constexpr size_t WS_XB = 64 * MiB;
constexpr size_t WS_X1 = 128 * MiB;
constexpr size_t WS_UV = 256 * MiB, WS_MIX = 320 * MiB;
constexpr size_t WS_ACT = 256 * MiB;
constexpr size_t WS_ERAW = 432 * MiB, WS_END = 496 * MiB;
static_assert(WS_ACT + (size_t)M * FF * 2 <= WS_ERAW && WS_WD + (size_t)D * FF * 2 <= WS_WPG && WS_WGU + (size_t)2 * FF * D * 2 <= WS_WD, "d_ws map");
constexpr int RING_BYTES = 131072, LDS_BYTES = 147456;

#define GAS __attribute__((address_space(1)))
#define LAS __attribute__((address_space(3)))
typedef unsigned short bf16;
typedef unsigned v4u __attribute__((ext_vector_type(4)));
typedef unsigned v2u __attribute__((ext_vector_type(2)));
typedef float f32x4 __attribute__((ext_vector_type(4)));
typedef float f32x2 __attribute__((ext_vector_type(2)));
#define LDS_WAIT() asm volatile("s_waitcnt lgkmcnt(0)" ::: "memory")
__device__ __forceinline__ unsigned pk2(float lo, float hi) { return pg8::cvt_pk_bf16(lo, hi); }
__device__ __forceinline__ float wave_sum(float v) {
#pragma unroll
    for (int o = 1; o < 64; o <<= 1) v += __shfl_xor(v, o);
    return v;
}

__device__ __forceinline__ void tr_item(const float* W, int ldw, bf16* WT, int ldwt, int k0, int n0, int drow0, const float* ksc, LAS float* scr, int lane) {
#pragma unroll 8
    for (int i = 0; i < 32; ++i) { const int kk = 2 * i + (lane >> 5); float v = W[(size_t)(k0 + kk) * ldw + n0 + (lane & 31)]; if (ksc) v *= ksc[k0 + kk]; scr[kk * 33 + (lane & 31)] = v; }
    LDS_WAIT(); asm volatile("" ::: "memory");
    const int c = lane & 7;
#pragma unroll
    for (int j = 0; j < 4; ++j) { const int n = (lane >> 3) + 8 * j; const LAS float* s = scr + (8 * c) * 33 + n;
        v4u o; o.x = pk2(s[0 * 33], s[1 * 33]); o.y = pk2(s[2 * 33], s[3 * 33]); o.z = pk2(s[4 * 33], s[5 * 33]); o.w = pk2(s[6 * 33], s[7 * 33]);
        *(GAS v4u*)(WT + (size_t)(drow0 + n) * ldwt + k0 + 8 * c) = o; }
    LDS_WAIT(); asm volatile("" ::: "memory");
}

struct Ptrs {
    const float *x, *p, *g_mix, *w_in, *conv_w, *conv_b, *ln_g, *ln_b, *pool_w, *pool_scale, *w_out, *g_ffn, *w_gu, *w_down, *g_pg, *w_pg, *w_pu, *g_post, *g_final;
    float* out; unsigned char* ws;
};

__device__ __forceinline__ void p0_prologue(const Ptrs& P, LAS unsigned char* lds, int vcu, int G) {
    const int lane = threadIdx.x & 63, wave = __builtin_amdgcn_readfirstlane(threadIdx.x >> 6);
    LAS float* scr = (LAS float*)(lds + wave * 16384);
    const int gw = vcu * NWAVES + wave, NGW = G * NWAVES;
    bf16* WinT = (bf16*)(P.ws + WS_WIN); bf16* WoutT = (bf16*)(P.ws + WS_WOUT); bf16* WguT = (bf16*)(P.ws + WS_WGU); bf16* WdT = (bf16*)(P.ws + WS_WD);
    bf16* WpgT = (bf16*)(P.ws + WS_WPG); bf16* WpuT = (bf16*)(P.ws + WS_WPU);
    constexpr int I_IN = 16 * 48, I_OUT = 8 * 32, I_GU = 16 * 176, I_D = 44 * 32, I_PG = 16 * 32, I_PU = 4 * 32, I_FOLD = 1024;
    constexpr int NITEMS = I_IN + I_OUT + I_GU + I_D + I_PG + I_PU + I_FOLD;
    for (int it = gw; it < NITEMS; it += NGW) {
        int r = it;
        if (r < I_IN) { const int kb = r / 48, n0 = 32 * (r % 48); const int dr = n0 < 1024 ? (((n0 & 511) >> 7) * 256 + (n0 >> 9) * 128 + (n0 & 127)) : n0;
            tr_item(P.w_in, NIN, WinT, D, 64 * kb, n0, dr, P.g_mix, scr, lane); continue; } r -= I_IN;
        if (r < I_OUT) { tr_item(P.w_out, D, WoutT, D, 64 * (r / 32), 32 * (r % 32), 32 * (r % 32), nullptr, scr, lane); continue; } r -= I_OUT;
        if (r < I_GU) { const int kb = r / 176, n0 = 32 * (r % 176), hf = n0 >= FF ? 1 : 0, rem = n0 - hf * FF; const int dr = (rem >> 7) * 256 + hf * 128 + (rem & 127);
            tr_item(P.w_gu, 2 * FF, WguT, D, 64 * kb, n0, dr, P.g_ffn, scr, lane); continue; } r -= I_GU;
        if (r < I_D) { tr_item(P.w_down, D, WdT, FF, 64 * (r / 32), 32 * (r % 32), 32 * (r % 32), nullptr, scr, lane); continue; } r -= I_D;
        if (r < I_PG) { tr_item(P.w_pg, D, WpgT, D, 64 * (r / 32), 32 * (r % 32), 32 * (r % 32), P.g_pg, scr, lane); continue; } r -= I_PG;
        if (r < I_PU) { tr_item(P.w_pu, D, WpuT, DPLE, 64 * (r / 32), 32 * (r % 32), 32 * (r % 32), nullptr, scr, lane); continue; } r -= I_PU;
        {
            const int g = r >> 8, c0 = 8 * ((r >> 4) & 15), n0 = 64 * (r & 15);
            const float* pw = P.pool_w + (size_t)(g * 128 + c0) * 128;
            float a[8];
#pragma unroll
            for (int c = 0; c < 8; ++c) a[c] = 0.f;
            for (int d = 0; d < 128; ++d) { const float wv = P.w_out[(size_t)(512 + g * 128 + d) * D + n0 + lane] * P.pool_scale[g * 128 + d];
#pragma unroll
                for (int c = 0; c < 8; ++c) a[c] += pw[c * 128 + d] * wv; }
            v4u o; o.x = pk2(a[0], a[1]); o.y = pk2(a[2], a[3]); o.z = pk2(a[4], a[5]); o.w = pk2(a[6], a[7]);
            *(GAS v4u*)(WoutT + (size_t)(n0 + lane) * D + 512 + g * 128 + c0) = o;
        }
    }
    bf16* XN = (bf16*)(P.ws + WS_XB);
    for (int m = gw; m < M; m += NGW) {
        const GAS f32x4* xr = (const GAS f32x4*)(P.x + (size_t)m * D) + lane;
        f32x4 v[4]; float s = 0.f;
#pragma unroll
        for (int j = 0; j < 4; ++j) { v[j] = xr[64 * j]; s += (v[j].x * v[j].x + v[j].y * v[j].y) + (v[j].z * v[j].z + v[j].w * v[j].w); }
        const float rstd = rsqrtf(wave_sum(s) * (1.f / D) + EPS);
        GAS v2u* o8 = (GAS v2u*)(XN + (size_t)m * D) + lane;
#pragma unroll
        for (int j = 0; j < 4; ++j) { v2u w; w.x = pk2(v[j].x * rstd, v[j].y * rstd); w.y = pk2(v[j].z * rstd, v[j].w * rstd); o8[64 * j] = w; }
    }
    bf16* PB = (bf16*)(P.ws + WS_PB);
    for (int m = gw; m < M; m += NGW) {
        const f32x4 v = *((const GAS f32x4*)(P.p + (size_t)m * DPLE) + lane);
        v2u w; w.x = pk2(v.x, v.y); w.y = pk2(v.z, v.w); *((GAS v2u*)(PB + (size_t)m * DPLE) + lane) = w;
    }
}

__device__ __forceinline__ void p2_mixer(const Ptrs& P, LAS unsigned char* lds, int G) {
    const int tid = threadIdx.x, half = __builtin_amdgcn_readfirstlane(tid >> 8), cp = tid & 255, lane = tid & 63;
    const int pg = __builtin_amdgcn_readfirstlane(tid >> 6) & 3;
    LAS float* red = (LAS float*)lds;
    LAS float* tot = (LAS float*)(lds + 65536);
    const GAS unsigned* UV32 = (const GAS unsigned*)(P.ws + WS_UV); GAS unsigned* MIX32 = (GAS unsigned*)(P.ws + WS_MIX);
    f32x2 w[CONVK];
#pragma unroll
    for (int k = 0; k < CONVK; ++k) w[k] = *(const f32x2*)(P.conv_w + k * CCONV + 2 * cp);
    const f32x2 cb = *(const f32x2*)(P.conv_b + 2 * cp), lg = *(const f32x2*)(P.ln_g + 2 * cp), lb = *(const f32x2*)(P.ln_b + 2 * cp);
    for (int unit = blockIdx.x; unit < M / 32; unit += G) {
        const int m0 = unit * 32 + half * 16, t0 = m0 & (SEQ - 1);
        unsigned uin[46], vin[31];
#pragma unroll
        for (int j = 0; j < 46; ++j) { const int dt = j - 30; const bool ok = (t0 + dt) >= 0; const unsigned v = UV32[(size_t)(ok ? m0 + dt : m0) * 512 + cp]; uin[j] = ok ? v : 0u; }
#pragma unroll
        for (int j = 0; j < 31; ++j) { const int dt = j - 15; const bool ok = (t0 + dt) >= 0; const unsigned v = UV32[(size_t)(ok ? m0 + dt : m0) * 512 + 256 + cp]; vin[j] = ok ? v : 0u; }
        f32x2 acc[16];
#pragma unroll
        for (int i = 0; i < 16; ++i) acc[i] = cb;
#pragma unroll
        for (int j = 0; j < 46; ++j) {
            const f32x2 uv = (f32x2){pg8::bf_lo(uin[j]), pg8::bf_hi(uin[j])};
#pragma unroll
            for (int i = 0; i < 16; ++i) { const int k = j - i; if (k >= 0 && k < CONVK) acc[i] += w[k] * uv; }
        }
#pragma unroll
        for (int i = 0; i < 16; ++i) { red[(half * 32 + i) * 256 + cp] = acc[i].x + acc[i].y; red[(half * 32 + 16 + i) * 256 + cp] = acc[i].x * acc[i].x + acc[i].y * acc[i].y; }
        LDS_WAIT(); __builtin_amdgcn_s_barrier(); asm volatile("" ::: "memory");
        { const int v = cp >> 3, s = cp & 7; float sum = 0.f;
#pragma unroll
            for (int j = 0; j < 32; ++j) sum += red[(half * 32 + v) * 256 + s * 32 + ((j + lane) & 31)];
            sum += __shfl_xor(sum, 1); sum += __shfl_xor(sum, 2); sum += __shfl_xor(sum, 4);
            if (s == 0) tot[half * 32 + v] = sum; }
        LDS_WAIT(); __builtin_amdgcn_s_barrier(); asm volatile("" ::: "memory");
        float st[32];
#pragma unroll
        for (int q = 0; q < 8; ++q) { const f32x4 t4 = *(const LAS f32x4*)(tot + half * 32 + 4 * q); st[4 * q] = t4.x; st[4 * q + 1] = t4.y; st[4 * q + 2] = t4.z; st[4 * q + 3] = t4.w; }
#pragma unroll
        for (int i = 0; i < 16; ++i) {
            const float mean = st[i] * (1.f / CCONV), var = st[16 + i] * (1.f / CCONV) - mean * mean, rstd = rsqrtf(var + EPS);
            const float y0 = (acc[i].x - mean) * rstd * lg.x + lb.x, y1 = (acc[i].y - mean) * rstd * lg.y + lb.y;
            MIX32[(size_t)(m0 + i) * 512 + cp] = pk2(y0 * pg8::sigm(y0), y1 * pg8::sigm(y1));
        }
        f32x2 sv[31], og[16];
#pragma unroll
        for (int j = 0; j < 31; ++j) sv[j] = (f32x2){pg8::bf_lo(vin[j]), pg8::bf_hi(vin[j])};
#pragma unroll
        for (int i = 0; i < 16; ++i) og[i] = sv[15 + i];
#pragma unroll
        for (int j = 30; j >= 1; --j) sv[j] += sv[j - 1];
        if (pg >= 1) {
#pragma unroll
            for (int j = 30; j >= 3; --j) sv[j] += sv[j - 2]; }
        if (pg >= 2) {
#pragma unroll
            for (int j = 30; j >= 7; --j) sv[j] += sv[j - 4]; }
        if (pg >= 3) {
#pragma unroll
            for (int j = 30; j >= 15; --j) sv[j] += sv[j - 8]; }
        const int wnd = 2 << pg;
#pragma unroll
        for (int i = 0; i < 16; ++i) { const int cnt = (t0 + i + 1) < wnd ? (t0 + i + 1) : wnd; const float inv = 1.0f / (float)cnt;
            MIX32[(size_t)(m0 + i) * 512 + 256 + cp] = pk2(sv[15 + i].x * inv - og[i].x, sv[15 + i].y * inv - og[i].y); }
    }
}

__device__ __forceinline__ void p8_final(const Ptrs& P, int vcu, int G) {
    const int lane = threadIdx.x & 63, wave = __builtin_amdgcn_readfirstlane(threadIdx.x >> 6);
    const int gw = vcu * NWAVES + wave, NGW = G * NWAVES;
    f32x4 gf[4];
#pragma unroll
    for (int j = 0; j < 4; ++j) gf[j] = *((const GAS f32x4*)P.g_final + lane + 64 * j);
    for (int m = gw; m < M; m += NGW) {
        GAS f32x4* xr = (GAS f32x4*)(P.out + (size_t)m * D) + lane;
        f32x4 v[4]; float s = 0.f;
#pragma unroll
        for (int j = 0; j < 4; ++j) { v[j] = xr[64 * j]; s += (v[j].x * v[j].x + v[j].y * v[j].y) + (v[j].z * v[j].z + v[j].w * v[j].w); }
        const float rstd = rsqrtf(wave_sum(s) * (1.f / D) + EPS);
#pragma unroll
        for (int j = 0; j < 4; ++j) xr[64 * j] = v[j] * rstd * gf[j];
    }
}

struct Args { const float* in[19]; float* out; unsigned char* ws; int ph_lo, ph_hi; };
static_assert(sizeof(Args) == 19 * 8 + 8 + 8 + 8, "Args has no padding");

__global__ void __launch_bounds__(NWAVES * 64, 2) fwd_megakernel(Args args) {
    __builtin_assume(__builtin_amdgcn_workitem_id_y() == 0); __builtin_assume(__builtin_amdgcn_workitem_id_z() == 0);
    extern __shared__ __attribute__((aligned(16))) unsigned char lds_raw[];
    LAS unsigned char* lds = (LAS unsigned char*)lds_raw;
    cg::grid_group grid = cg::this_grid();
    const int G = gridDim.x, bx = blockIdx.x, vcu = (G % 8 == 0) ? (bx % 8) * (G / 8) + bx / 8 : bx;
    Ptrs P;
    P.x = args.in[0]; P.p = args.in[1]; P.g_mix = args.in[2]; P.w_in = args.in[3]; P.conv_w = args.in[4]; P.conv_b = args.in[5]; P.ln_g = args.in[6]; P.ln_b = args.in[7];
    P.pool_w = args.in[8]; P.pool_scale = args.in[9]; P.w_out = args.in[10]; P.g_ffn = args.in[11]; P.w_gu = args.in[12]; P.w_down = args.in[13]; P.g_pg = args.in[14];
    P.w_pg = args.in[15]; P.w_pu = args.in[16]; P.g_post = args.in[17]; P.g_final = args.in[18]; P.out = args.out; P.ws = args.ws;
    unsigned char* ws = args.ws;
    pg8::bf16_t* WinT = (pg8::bf16_t*)(ws + WS_WIN); pg8::bf16_t* WoutT = (pg8::bf16_t*)(ws + WS_WOUT); pg8::bf16_t* WguT = (pg8::bf16_t*)(ws + WS_WGU); pg8::bf16_t* WdT = (pg8::bf16_t*)(ws + WS_WD);
    pg8::bf16_t* WpgT = (pg8::bf16_t*)(ws + WS_WPG); pg8::bf16_t* WpuT = (pg8::bf16_t*)(ws + WS_WPU);
    pg8::bf16_t* XB = (pg8::bf16_t*)(ws + WS_XB); pg8::bf16_t* PB = (pg8::bf16_t*)(ws + WS_PB); pg8::bf16_t* UV = (pg8::bf16_t*)(ws + WS_UV); pg8::bf16_t* MIX = (pg8::bf16_t*)(ws + WS_MIX);
    pg8::bf16_t* ACT = (pg8::bf16_t*)(ws + WS_ACT); pg8::bf16_t* ERAW = (pg8::bf16_t*)(ws + WS_ERAW);
    float* X1 = (float*)(ws + WS_X1); float* SSQ2 = (float*)(ws + WS_SSQ2); float* SSQ3 = (float*)(ws + WS_SSQ3); float* SSQE = (float*)(ws + WS_SSQE);

    const int lo = args.ph_lo, hi = args.ph_hi;
#define IN(k) (lo <= (k) && (k) < hi)
#define SEAM(k) do { if (IN(k) && IN((k) + 1)) grid.sync(); } while (0)

    if (IN(0)) { p0_prologue(P, lds, vcu, G); __syncthreads(); }
    SEAM(0);
    if (IN(1)) { pg8::Gemm g{XB, WinT, M, NIN, D}; pg8::StaticOrder S; S.init(M, NIN, G, bx); pg8::EpiGlu E{UV};
        pg8::gemm_phase<pg8::EpiGlu, pg8::StaticOrder, PG8_ALIGN, PG8_SP2>(lds, g, S, E); }
    SEAM(1);
    if (IN(2)) { p2_mixer(P, lds, G); __syncthreads(); }
    SEAM(2);
    if (IN(3)) { pg8::Gemm g{MIX, WoutT, M, D, D}; pg8::StaticOrder S; S.init(M, D, G, bx); pg8::EpiRes E{P.x, X1, XB, SSQ2};
        pg8::gemm_phase<pg8::EpiRes, pg8::StaticOrder, PG8_ALIGN, PG8_SP2>(lds, g, S, E); }
    SEAM(3);
    if (IN(4)) { pg8::Gemm g{XB, WguT, M, 2 * FF, D}; pg8::StaticOrder S; S.init(M, 2 * FF, G, bx); pg8::EpiSwiglu E{ACT, FF, SSQ2};
        pg8::gemm_phase<pg8::EpiSwiglu, pg8::StaticOrder, PG8_ALIGN, PG8_SP2>(lds, g, S, E); }
    SEAM(4);
    if (IN(5)) { pg8::Gemm g{ACT, WdT, M, D, FF}; pg8::StaticOrder S; S.init(M, D, G, bx); pg8::EpiRes E{X1, P.out, XB, SSQ3};
        pg8::gemm_phase<pg8::EpiRes, pg8::StaticOrder, PG8_ALIGN, PG8_SP2>(lds, g, S, E); }
    if (IN(6)) { pg8::Gemm g{PB, WpuT, M, D, DPLE}; pg8::StaticOrder S; S.init(M, D, G, bx); pg8::EpiRaw E{ERAW, SSQE};
        pg8::gemm_phase<pg8::EpiRaw, pg8::StaticOrder, PG8_ALIGN, PG8_SP2>(lds, g, S, E); }
    SEAM(6);
    if (IN(7)) { pg8::Gemm g{XB, WpgT, M, D, D}; pg8::StaticOrder S; S.init(M, D, G, bx); pg8::EpiPle E{P.out, ERAW, SSQ3, SSQE, P.g_post};
        pg8::gemm_phase<pg8::EpiPle, pg8::StaticOrder, PG8_ALIGN, PG8_SP2>(lds, g, S, E); }
    SEAM(7);
    if (IN(8)) p8_final(P, vcu, G);
#undef IN
#undef SEAM
}

extern "C" void kernel_launch(void* const* d_in, const int* in_sizes, int n_in, void* d_out, int out_size, void* d_ws, size_t ws_size, hipStream_t stream) {
    static int grid = 0;
    if (grid == 0) {
        if (n_in != 19 || in_sizes[0] != M * D || out_size != M * D || ws_size < WS_END) { fprintf(stderr, "kernel_launch: unexpected shapes (n_in %d, in0 %d, out %d, ws %zu); nothing launched\n", n_in, n_in > 0 ? in_sizes[0] : -1, out_size, ws_size); grid = -1; return; }
        int dev = 0, cus = 0, per_cu = 0;
        if (hipGetDevice(&dev) != hipSuccess || hipDeviceGetAttribute(&cus, hipDeviceAttributeMultiprocessorCount, dev) != hipSuccess) { grid = -1; return; }
        if (hipFuncSetAttribute((const void*)fwd_megakernel, hipFuncAttributeMaxDynamicSharedMemorySize, LDS_BYTES) != hipSuccess) { fprintf(stderr, "kernel_launch: hipFuncSetAttribute failed\n"); grid = -1; return; }
        if (hipOccupancyMaxActiveBlocksPerMultiprocessor(&per_cu, (const void*)fwd_megakernel, NWAVES * 64, LDS_BYTES) != hipSuccess || per_cu < 1) { fprintf(stderr, "kernel_launch: occupancy query says %d blocks per CU; nothing launched\n", per_cu); (void)hipGetLastError(); grid = -1; return; }
        grid = cus;
    }
    if (grid < 0) return;
    Args a{};
    for (int i = 0; i < 19; ++i) a.in[i] = (const float*)d_in[i];
    a.out = (float*)d_out; a.ws = (unsigned char*)d_ws;
    if (N_LAUNCHES == 1) {
        a.ph_lo = 0; a.ph_hi = N_PHASES;
        void* params[] = {&a};
        const hipError_t e = hipLaunchCooperativeKernel((const void*)fwd_megakernel, dim3(grid), dim3(NWAVES * 64), params, LDS_BYTES, stream);
        if (e != hipSuccess) fprintf(stderr, "kernel_launch: cooperative launch failed: %s (grid %d)\n", hipGetErrorString(e), grid);
    } else {
        for (int li = 0; li < N_PHASES; ++li) { a.ph_lo = li; a.ph_hi = li + 1; hipLaunchKernelGGL(fwd_megakernel, dim3(grid), dim3(NWAVES * 64), LDS_BYTES, stream, a); }
    }
}
```

```cpp
#include <hip/hip_runtime.h>
#include <cstdio>
#include <cstdint>
namespace pg8 {
#define PG8_LAS __attribute__((address_space(3)))
typedef unsigned short bf16_t;
typedef short bf16x8 __attribute__((ext_vector_type(8)));
typedef float f32x4 __attribute__((ext_vector_type(4)));
typedef unsigned u32x4 __attribute__((ext_vector_type(4)));
constexpr int BM = 256, BK = 64, HALF = 128, HTB = HALF * BK * 2  , STAGE_BYTES = 8 * HTB, NXCD = 8, WGM = 8;

__host__ __device__ __forceinline__ int lds_byte(int r, int c) { const int st = (r >> 4) * 2 + (c >> 5), rr = r & 15, cc = c & 31, ob = rr * 64 + cc * 2; return st * 1024 + (ob ^ (((ob >> 9) & 1) << 5)); }
__host__ __device__ __forceinline__ void stage_rc(int b, int& R, int& C) { const int st = b / 1024, sb = b % 1024, swz = sb ^ (((sb >> 9) & 1) << 5); R = (st >> 1) * 16 + swz / 64; C = (st & 1) * 32 + (swz % 64) / 2; }
__host__ __device__ __forceinline__ int perm32(int rho) { const int n = rho >> 4, i = rho & 15; return 8 * (i >> 2) + 4 * n + (i & 3); }

struct Unit { int pm, pn; };
struct Gemm { const bf16_t* A; const bf16_t* Bt; int M, N, K; };

struct StaticOrder {
    int nM, nN, nwg, G, c, lim;
    __host__ __device__ void init(int M, int N, int G_, int c_, int rep = 1) { nM = M / BM; nN = N / BM; nwg = nM * nN; G = G_; c = c_; lim = nwg * rep; }
    __host__ __device__ bool next(int i, Unit& u) const {
        const long L = (long)i * G + c; if (L >= lim) return false;
        int wgid = (int)(L % nwg); { const int q = nwg / NXCD, r = nwg % NXCD, xcd = wgid % NXCD, off = wgid / NXCD; wgid = (xcd < r ? xcd * (q + 1) : r * (q + 1) + (xcd - r) * q) + off; }
        const int nig = WGM * nN, gid = wgid / nig, fm = gid * WGM, gsz = (nM - fm) < WGM ? (nM - fm) : WGM;
        u.pm = fm + ((wgid % nig) % gsz); u.pn = (wgid % nig) / gsz; return true;
    }
    __device__ __forceinline__ void a_ready(const Unit&) const {}
    __device__ __forceinline__ void done(const Unit&) const {}
};

__device__ __forceinline__ unsigned cvt_pk_bf16(float lo, float hi) { unsigned r; asm volatile("v_cvt_pk_bf16_f32 %0, %1, %2" : "=v"(r) : "v"(lo), "v"(hi)); return r; }
typedef float f32x2 __attribute__((ext_vector_type(2)));
constexpr float RMS_EPS = 1e-6f;
__device__ __forceinline__ float sigm(float x) { return __builtin_amdgcn_rcpf(1.0f + __builtin_amdgcn_exp2f(-1.4426950408889634f * x)); }
__device__ __forceinline__ u32x4 pack8(const f32x4 a, const f32x4 b) { u32x4 w; w.x = cvt_pk_bf16(a[0], a[1]); w.y = cvt_pk_bf16(a[2], a[3]); w.z = cvt_pk_bf16(b[0], b[1]); w.w = cvt_pk_bf16(b[2], b[3]); return w; }
__device__ __forceinline__ float bf_lo(unsigned w) { return __uint_as_float(w << 16); }
__device__ __forceinline__ float bf_hi(unsigned w) { return __uint_as_float(w & 0xffff0000u); }
__device__ __forceinline__ float row_rstd(const float* ssq, int r, int fq) {
    const f32x4 p = *(const f32x4*)(ssq + (size_t)r * 16 + 4 * fq);
    float s = (p[0] + p[1]) + (p[2] + p[3]); s += __shfl_xor(s, 16); s += __shfl_xor(s, 32);
    return rsqrtf(s * (1.0f / 1024.0f) + RMS_EPS);
}

struct EpiGlu {
    static constexpr bool PERM = true, AFTER_DRAIN = false;
    bf16_t* UV;
    __device__ __forceinline__ void operator()(const f32x4 (&acc)[2][2][4][2], const Unit& u, int wr, int wc, int fr, int fq) const {
        const int row0 = u.pm * BM + wr * 64 + fr;
        if (u.pn < 4) {
            const int col0 = u.pn * 128 + wc * 32 + 8 * fq;
#pragma unroll
            for (int ai = 0; ai < 2; ++ai)
#pragma unroll
                for (int m = 0; m < 4; ++m) {
                    f32x4 o[2];
#pragma unroll
                    for (int n = 0; n < 2; ++n)
#pragma unroll
                        for (int i = 0; i < 4; ++i) o[n][i] = acc[ai][0][m][n][i] * sigm(acc[ai][1][m][n][i]);
                    *(u32x4*)(UV + (size_t)(row0 + ai * HALF + m * 16) * 1024 + col0) = pack8(o[0], o[1]);
                }
        } else {
            const int col0 = 512 + (u.pn - 4) * 256 + wc * 32 + 8 * fq;
#pragma unroll
            for (int ai = 0; ai < 2; ++ai)
#pragma unroll
                for (int m = 0; m < 4; ++m)
#pragma unroll
                    for (int bj = 0; bj < 2; ++bj)
                        *(u32x4*)(UV + (size_t)(row0 + ai * HALF + m * 16) * 1024 + col0 + bj * HALF) = pack8(acc[ai][bj][m][0], acc[ai][bj][m][1]);
        }
    }
};

struct EpiSwiglu {
    static constexpr bool PERM = true, AFTER_DRAIN = false;
    bf16_t* ACT; int ldc; const float* ssq;
    __device__ __forceinline__ void operator()(const f32x4 (&acc)[2][2][4][2], const Unit& u, int wr, int wc, int fr, int fq) const {
        const int row0 = u.pm * BM + wr * 64 + fr, col0 = u.pn * 128 + wc * 32 + 8 * fq;
        float rs[2][4];
#pragma unroll
        for (int ai = 0; ai < 2; ++ai)
#pragma unroll
            for (int m = 0; m < 4; ++m) rs[ai][m] = row_rstd(ssq, row0 + ai * HALF + m * 16, fq);
#pragma unroll
        for (int ai = 0; ai < 2; ++ai)
#pragma unroll
            for (int m = 0; m < 4; ++m) {
                f32x4 o[2]; const float r = rs[ai][m];
#pragma unroll
                for (int n = 0; n < 2; ++n)
#pragma unroll
                    for (int i = 0; i < 4; ++i) { const float g = acc[ai][0][m][n][i] * r, up = acc[ai][1][m][n][i] * r; o[n][i] = g * sigm(g) * up; }
                *(u32x4*)(ACT + (size_t)(row0 + ai * HALF + m * 16) * ldc + col0) = pack8(o[0], o[1]);
            }
    }
};

struct EpiRes {
    static constexpr bool PERM = true, AFTER_DRAIN = false;
    const float* base; float* out32; bf16_t* outb; float* ssq;
    __device__ __forceinline__ void operator()(const f32x4 (&acc)[2][2][4][2], const Unit& u, int wr, int wc, int fr, int fq) const {
        const int row0 = u.pm * BM + wr * 64 + fr, col0 = u.pn * BM + wc * 32 + 8 * fq;
#pragma unroll
        for (int ai = 0; ai < 2; ++ai)
#pragma unroll
            for (int m = 0; m < 4; ++m) {
                const int r = row0 + ai * HALF + m * 16; float q = 0.f;
#pragma unroll
                for (int bj = 0; bj < 2; ++bj) {
                    const size_t off = (size_t)r * 1024 + col0 + bj * HALF;
                    const f32x4 v0 = *(const f32x4*)(base + off) + acc[ai][bj][m][0], v1 = *(const f32x4*)(base + off + 4) + acc[ai][bj][m][1];
                    *(f32x4*)(out32 + off) = v0; *(f32x4*)(out32 + off + 4) = v1;
                    *(u32x4*)(outb + off) = pack8(v0, v1);
                    q += (v0[0] * v0[0] + v0[1] * v0[1]) + (v0[2] * v0[2] + v0[3] * v0[3]) + (v1[0] * v1[0] + v1[1] * v1[1]) + (v1[2] * v1[2] + v1[3] * v1[3]);
                }
                q += __shfl_xor(q, 16); q += __shfl_xor(q, 32);
                if (fq == 0) ssq[(size_t)r * 16 + u.pn * 4 + wc] = q;
            }
    }
};

struct EpiRaw {
    static constexpr bool PERM = true, AFTER_DRAIN = false;
    bf16_t* outb; float* ssq;
    __device__ __forceinline__ void operator()(const f32x4 (&acc)[2][2][4][2], const Unit& u, int wr, int wc, int fr, int fq) const {
        const int row0 = u.pm * BM + wr * 64 + fr, col0 = u.pn * BM + wc * 32 + 8 * fq;
#pragma unroll
        for (int ai = 0; ai < 2; ++ai)
#pragma unroll
            for (int m = 0; m < 4; ++m) {
                const int r = row0 + ai * HALF + m * 16; float q = 0.f;
#pragma unroll
                for (int bj = 0; bj < 2; ++bj) {
                    const size_t off = (size_t)r * 1024 + col0 + bj * HALF;
                    const f32x4 v0 = acc[ai][bj][m][0], v1 = acc[ai][bj][m][1];
                    *(u32x4*)(outb + off) = pack8(v0, v1);
                    q += (v0[0] * v0[0] + v0[1] * v0[1]) + (v0[2] * v0[2] + v0[3] * v0[3]) + (v1[0] * v1[0] + v1[1] * v1[1]) + (v1[2] * v1[2] + v1[3] * v1[3]);
                }
                q += __shfl_xor(q, 16); q += __shfl_xor(q, 32);
                if (fq == 0) ssq[(size_t)r * 16 + u.pn * 4 + wc] = q;
            }
    }
};

struct EpiPle {
    static constexpr bool PERM = true, AFTER_DRAIN = false;
    const float* xin; float* xout; const bf16_t* eraw; const float* ssq3; const float* ssqe; const float* gpost;
    __device__ __forceinline__ void operator()(const f32x4 (&acc)[2][2][4][2], const Unit& u, int wr, int wc, int fr, int fq) const {
        const int row0 = u.pm * BM + wr * 64 + fr, col0 = u.pn * BM + wc * 32 + 8 * fq;
        f32x4 gp[2][2];
#pragma unroll
        for (int bj = 0; bj < 2; ++bj)
#pragma unroll
            for (int n = 0; n < 2; ++n) gp[bj][n] = *(const f32x4*)(gpost + col0 + bj * HALF + 4 * n);
#pragma unroll
        for (int ai = 0; ai < 2; ++ai)
#pragma unroll
            for (int m = 0; m < 4; ++m) {
                const int r = row0 + ai * HALF + m * 16;
                const float r3 = row_rstd(ssq3, r, fq), re = row_rstd(ssqe, r, fq);
#pragma unroll
                for (int bj = 0; bj < 2; ++bj) {
                    const size_t off = (size_t)r * 1024 + col0 + bj * HALF;
                    const u32x4 ew = *(const u32x4*)(eraw + off);
                    f32x4 e0 = (f32x4){bf_lo(ew.x), bf_hi(ew.x), bf_lo(ew.y), bf_hi(ew.y)}, e1 = (f32x4){bf_lo(ew.z), bf_hi(ew.z), bf_lo(ew.w), bf_hi(ew.w)};
                    f32x4 x0 = *(const f32x4*)(xin + off), x1 = *(const f32x4*)(xin + off + 4);
#pragma unroll
                    for (int i = 0; i < 4; ++i) { x0[i] += sigm(acc[ai][bj][m][0][i] * r3) * (e0[i] * re * gp[bj][0][i]); x1[i] += sigm(acc[ai][bj][m][1][i] * r3) * (e1[i] * re * gp[bj][1][i]); }
                    *(f32x4*)(xout + off) = x0; *(f32x4*)(xout + off + 4) = x1;
                }
            }
    }
};

template <class Epi, class Sched, bool ALIGN_EPI = false, bool SP2 = false>
__device__ __forceinline__ void gemm_phase(PG8_LAS unsigned char* lds, const Gemm g, const Sched& S, const Epi& E) {
    const int tid = threadIdx.x, wid = __builtin_amdgcn_readfirstlane(tid >> 6), lane = tid & 63, wr = wid >> 2, wc = wid & 3, fr = lane & 15, fq = lane >> 4;
    const int K = g.K, nt = K / BK;
    unsigned voffA[2], voffB[2];
#pragma unroll
    for (int i = 0; i < 2; ++i) { int R, C; stage_rc(tid * 16 + i * 8192, R, C); const int Rb = Epi::PERM ? ((R & ~31) + perm32(R & 31)) : R;
        voffA[i] = (unsigned)(R * K + C) * 2u; voffB[i] = (unsigned)(Rb * K + C) * 2u; }
    const size_t kstep = (size_t)(BK * 2);
    const size_t hstep = (size_t)HALF * K * 2;
    const size_t tstep = 2 * hstep;
    const unsigned ldsw = (unsigned)wid * 1024u;
    const int aoff = lds_byte(wr * 64 + fr, fq * 8), boff = lds_byte(wc * 32 + fr, fq * 8);
#define PG8_SA(b, h) (((b) * 2 + (h)) * HTB)
#define PG8_SB(b, h) ((4 + (b) * 2 + (h)) * HTB)
#define PG8_STAGE(bufoff, gbase, voff) do { _Pragma("unroll") for (int _i = 0; _i < 2; ++_i) \
        __builtin_amdgcn_global_load_lds((const unsigned*)((const char*)(gbase) + (voff)[_i]), (PG8_LAS unsigned*)(lds + (bufoff) + ldsw + _i * 8192), 16, 0, 0); } while (0)
#define PG8_LDA(dst, b, h) do { _Pragma("unroll") for (int m = 0; m < 4; ++m) _Pragma("unroll") for (int k = 0; k < 2; ++k) dst[m][k] = *(const PG8_LAS bf16x8*)(lds + PG8_SA(b, h) + aoff + m * 2048 + k * 1024); } while (0)
#define PG8_LDB(dst, b, h) do { _Pragma("unroll") for (int n = 0; n < 2; ++n) _Pragma("unroll") for (int k = 0; k < 2; ++k) dst[n][k] = *(const PG8_LAS bf16x8*)(lds + PG8_SB(b, h) + boff + n * 2048 + k * 1024); } while (0)
#define PG8_MMA(ai, bj, At, Bt) do { __builtin_amdgcn_s_setprio(1); _Pragma("unroll") for (int m = 0; m < 4; ++m) _Pragma("unroll") for (int n = 0; n < 2; ++n) _Pragma("unroll") for (int k = 0; k < 2; ++k) \
        acc[ai][bj][m][n] = __builtin_amdgcn_mfma_f32_16x16x32_bf16(Bt[n][k], At[m][k], acc[ai][bj][m][n], 0, 0, 0); __builtin_amdgcn_s_setprio(0); } while (0)
#define PG8_WAIT_V(n) asm volatile("s_waitcnt vmcnt(" #n ")" ::: "memory")
#define PG8_WAIT_L(n) asm volatile("s_waitcnt lgkmcnt(" #n ")" ::: "memory")
#define PG8_BAR __builtin_amdgcn_s_barrier()
#define PG8_SCHED __builtin_amdgcn_sched_barrier(0)
    Unit cur, nxt; int ui = 0;
    if (!S.next(0, cur)) return;
    f32x4 acc[2][2][4][2];
#pragma unroll
    for (int a = 0; a < 2; ++a)
#pragma unroll
        for (int b = 0; b < 2; ++b)
#pragma unroll
            for (int m = 0; m < 4; ++m)
#pragma unroll
                for (int n = 0; n < 2; ++n) acc[a][b][m][n] = (f32x4){0.f, 0.f, 0.f, 0.f};
    bf16x8 At[4][2], B0[2][2], B1[2][2];
    const char* cA = (const char*)g.A + (size_t)cur.pm * tstep; const char* cB = (const char*)g.Bt + (size_t)cur.pn * tstep;
    S.a_ready(cur);
    if constexpr (SP2) {
        PG8_STAGE(PG8_SB(0, 0), cB, voffB); PG8_STAGE(PG8_SB(0, 1), cB + hstep, voffB); PG8_STAGE(PG8_SA(0, 0), cA, voffA); PG8_STAGE(PG8_SA(0, 1), cA + hstep, voffA);
        if (wr == 1) PG8_BAR;
        PG8_WAIT_V(2); PG8_BAR;
        PG8_STAGE(PG8_SB(1, 0), cB + kstep, voffB); PG8_STAGE(PG8_SA(1, 0), cA + kstep, voffA); PG8_STAGE(PG8_SB(1, 1), cB + hstep + kstep, voffB);
        PG8_WAIT_V(6); PG8_BAR;
    } else {
        PG8_STAGE(PG8_SB(0, 0), cB, voffB); PG8_STAGE(PG8_SA(0, 0), cA, voffA); PG8_STAGE(PG8_SB(0, 1), cB + hstep, voffB); PG8_STAGE(PG8_SA(0, 1), cA + hstep, voffA);
        if (wr == 1) PG8_BAR;
        PG8_WAIT_V(4); PG8_BAR;
        PG8_STAGE(PG8_SB(1, 0), cB + kstep, voffB); PG8_STAGE(PG8_SA(1, 0), cA + kstep, voffA); PG8_STAGE(PG8_SB(1, 1), cB + hstep + kstep, voffB);
        PG8_WAIT_V(6); PG8_BAR;
    }
    for (;;) {
        const bool has_next = S.next(ui + 1, nxt);
        const char* nA = has_next ? (const char*)g.A + (size_t)nxt.pm * tstep : cA; const char* nB = has_next ? (const char*)g.Bt + (size_t)nxt.pn * tstep : cB;
        for (int t = 0; t < nt; t += 2) {
            const bool last = (t == nt - 2);
            const char* a1 = cA + (size_t)(t + 1) * kstep;
            const char* a2 = last ? nA : cA + (size_t)(t + 2) * kstep; const char* b2 = last ? nB : cB + (size_t)(t + 2) * kstep;
            const char* a3 = a2 + kstep; const char* b3 = b2 + kstep;
            if (last && has_next) S.a_ready(nxt);
            if constexpr (SP2) {
            PG8_LDB(B0, 0, 0); PG8_LDB(B1, 0, 1); PG8_SCHED; PG8_LDA(At, 0, 0); PG8_STAGE(PG8_SA(1, 1), a1 + hstep, voffA);
            PG8_WAIT_V(8); PG8_WAIT_L(0); PG8_BAR; PG8_MMA(0, 0, At, B0); PG8_MMA(0, 1, At, B1); PG8_BAR; PG8_SCHED;
            PG8_LDA(At, 0, 1); PG8_STAGE(PG8_SB(0, 0), b2, voffB); PG8_STAGE(PG8_SB(0, 1), b2 + hstep, voffB); PG8_STAGE(PG8_SA(0, 0), a2, voffA);
            PG8_WAIT_V(8); PG8_WAIT_L(0); PG8_BAR; PG8_MMA(1, 0, At, B0); PG8_MMA(1, 1, At, B1); PG8_BAR; PG8_SCHED;
            PG8_LDB(B0, 1, 0); PG8_LDB(B1, 1, 1); PG8_SCHED; PG8_LDA(At, 1, 0); PG8_STAGE(PG8_SA(0, 1), a2 + hstep, voffA);
            PG8_WAIT_V(8); PG8_WAIT_L(0); PG8_BAR; PG8_MMA(0, 0, At, B0); PG8_MMA(0, 1, At, B1); PG8_BAR; PG8_SCHED;
            PG8_LDA(At, 1, 1); PG8_STAGE(PG8_SB(1, 0), b3, voffB); PG8_STAGE(PG8_SB(1, 1), b3 + hstep, voffB); PG8_STAGE(PG8_SA(1, 0), a3, voffA);
            PG8_WAIT_V(8); PG8_WAIT_L(0); PG8_BAR; PG8_MMA(1, 0, At, B0); PG8_MMA(1, 1, At, B1); PG8_BAR; PG8_SCHED;
            } else {
            PG8_LDB(B0, 0, 0); PG8_SCHED; PG8_LDA(At, 0, 0); PG8_STAGE(PG8_SA(1, 1), a1 + hstep, voffA);
            PG8_WAIT_L(8); PG8_BAR; PG8_WAIT_L(0); PG8_MMA(0, 0, At, B0); PG8_BAR; PG8_SCHED;
            PG8_LDB(B1, 0, 1); PG8_STAGE(PG8_SB(0, 0), b2, voffB);
            PG8_BAR; PG8_WAIT_L(0); PG8_MMA(0, 1, At, B1); PG8_BAR;
            PG8_LDA(At, 0, 1); PG8_STAGE(PG8_SA(0, 0), a2, voffA);
            PG8_BAR; PG8_WAIT_L(0); PG8_MMA(1, 0, At, B0); PG8_BAR; PG8_SCHED;
            PG8_STAGE(PG8_SB(0, 1), b2 + hstep, voffB);
            PG8_WAIT_V(6); PG8_BAR; PG8_MMA(1, 1, At, B1); PG8_BAR;
            PG8_LDB(B0, 1, 0); PG8_SCHED; PG8_LDA(At, 1, 0); PG8_STAGE(PG8_SA(0, 1), a2 + hstep, voffA);
            PG8_WAIT_L(8); PG8_BAR; PG8_WAIT_L(0); PG8_MMA(0, 0, At, B0); PG8_BAR; PG8_SCHED;
            PG8_LDB(B1, 1, 1); PG8_STAGE(PG8_SB(1, 0), b3, voffB);
            PG8_BAR; PG8_WAIT_L(0); PG8_MMA(0, 1, At, B1); PG8_BAR;
            PG8_LDA(At, 1, 1); PG8_STAGE(PG8_SA(1, 0), a3, voffA);
            PG8_BAR; PG8_WAIT_L(0); PG8_MMA(1, 0, At, B0); PG8_BAR; PG8_SCHED;
            PG8_STAGE(PG8_SB(1, 1), b3 + hstep, voffB);
            PG8_WAIT_V(6); PG8_BAR; PG8_MMA(1, 1, At, B1); PG8_BAR;
            }
        }
        if constexpr (ALIGN_EPI) { if (wr == 0) PG8_BAR; }
        if constexpr (!Epi::AFTER_DRAIN) { E(acc, cur, wr, wc, fr, fq); S.done(cur); }
        if (!has_next) break;
#pragma unroll
        for (int a = 0; a < 2; ++a)
#pragma unroll
            for (int b = 0; b < 2; ++b)
#pragma unroll
                for (int m = 0; m < 4; ++m)
#pragma unroll
                    for (int n = 0; n < 2; ++n) acc[a][b][m][n] = (f32x4){0.f, 0.f, 0.f, 0.f};
        cur = nxt; cA = nA; cB = nB; ++ui;
        if constexpr (ALIGN_EPI) { if (wr == 1) PG8_BAR; }
    }
    PG8_WAIT_V(0);
    if constexpr (!ALIGN_EPI) { if (wr == 0) PG8_BAR; }
    PG8_BAR;
    if constexpr (Epi::AFTER_DRAIN) { E.fused(acc, cur, wr, wc, fr, fq, lds, wid, lane); S.done(cur); }
#undef PG8_SA
#undef PG8_SB
#undef PG8_STAGE
#undef PG8_LDA
#undef PG8_LDB
#undef PG8_MMA
#undef PG8_WAIT_V
#undef PG8_WAIT_L
#undef PG8_BAR
#undef PG8_SCHED
}
}
#ifndef PG8_SP2
#define PG8_SP2 true
#endif
#ifndef PG8_ALIGN
#define PG8_ALIGN true
#endif
constexpr int NWAVES = 8;
#ifndef MK_N_LAUNCHES
#define MK_N_LAUNCHES 1
#endif
constexpr int N_PHASES = 9;
constexpr int N_LAUNCHES = MK_N_LAUNCHES;

constexpr int BATCH = 8, SEQ = 4096, D = 1024, M = BATCH * SEQ, NIN = 1536, CCONV = 512, FF = 2816, DPLE = 256, CONVK = 31;
constexpr float EPS = 1e-6f;
constexpr size_t MiB = 1u << 20;
constexpr size_t WS_CTL = 0, CTL_ZERO_BYTES = 65536;
constexpr size_t WS_WIN = 2 * MiB, WS_WOUT = 5 * MiB, WS_WGU = 7 * MiB, WS_WD = 18 * MiB, WS_WPG = 24 * MiB, WS_WPU = 26 * MiB;
constexpr size_t WS_SSQ2 = 30 * MiB, WS_SSQ3 = 32 * MiB, WS_SSQE = 34 * MiB;
constexpr size_t WS_PB = 40 * MiB;
constexpr size_t WS_XB = 64 * MiB;
constexpr size_t WS_X1 = 128 * MiB;
constexpr size_t WS_UV = 256 * MiB, WS_MIX = 320 * MiB;
constexpr size_t WS_ACT = 256 * MiB;
constexpr size_t WS_ERAW = 432 * MiB, WS_END = 496 * MiB;
static_assert(WS_ACT + (size_t)M * FF * 2 <= WS_ERAW && WS_WD + (size_t)D * FF * 2 <= WS_WPG && WS_WGU + (size_t)2 * FF * D * 2 <= WS_WD, "d_ws map");
constexpr int RING_BYTES = 131072, MISC_OFF = RING_BYTES + 320, LDS_BYTES = 147456;

#define GAS __attribute__((address_space(1)))
#define LAS __attribute__((address_space(3)))
typedef unsigned short bf16;
typedef unsigned v4u __attribute__((ext_vector_type(4)));
typedef unsigned v2u __attribute__((ext_vector_type(2)));
typedef float f32x4 __attribute__((ext_vector_type(4)));
typedef float f32x2 __attribute__((ext_vector_type(2)));
#define LDS_WAIT() asm volatile("s_waitcnt lgkmcnt(0)" ::: "memory")
__device__ __forceinline__ unsigned pk2(float lo, float hi) { return pg8::cvt_pk_bf16(lo, hi); }
__device__ __forceinline__ float wave_sum(float v) {
#pragma unroll
    for (int o = 1; o < 64; o <<= 1) v += __shfl_xor(v, o);
    return v;
}

#define RLX_AGENT __ATOMIC_RELAXED, __HIP_MEMORY_SCOPE_AGENT
#define XB_TMO      128
#define XB_XCNT(j)  (256  + 64 * (j))
#define XB_XSUB(j)  (1280 + 64 * (j))
#define XB_XGEN(j)  (2304 + 64 * (j))
#define XB_TOP      3328
#define XB_TOPGEN   3392
#define XCD_BAR_WORDS 3456
#define XB_SPIN_CAP (1u << 18)

__device__ __forceinline__ unsigned xb_ld(unsigned* p)              { return __hip_atomic_load(p, __ATOMIC_RELAXED, __HIP_MEMORY_SCOPE_AGENT); }
__device__ __forceinline__ unsigned xb_add(unsigned* p, unsigned v) { return __hip_atomic_fetch_add(p, v, __ATOMIC_RELAXED, __HIP_MEMORY_SCOPE_AGENT); }
__device__ __forceinline__ unsigned xb_xcc_id() { return (unsigned)__builtin_amdgcn_s_getreg((3 << 11) | 20) & 0xFu; }
#define XB_SPIN(cond, bar) do { unsigned _sp = 0; while (cond) { __builtin_amdgcn_s_sleep(1); \
    if ((++_sp & 255u) == 0u) { if (xb_ld(&(bar)[XB_TMO])) break; if (_sp > XB_SPIN_CAP) { atomicAdd(&(bar)[XB_TMO], 1u); break; } } } } while (0)

struct XcdBarrier {
    unsigned* bar; unsigned x;
    volatile LAS unsigned* st;
};

__device__ __forceinline__ XcdBarrier xcd_barrier_post(unsigned* bar, volatile LAS unsigned* st) {
    XcdBarrier b; b.bar = bar; b.x = xb_xcc_id(); b.st = st;
    if (threadIdx.x == 0) (void)xb_add(&bar[XB_XCNT(b.x)], 1u);
    return b;
}
__device__ __forceinline__ void xcd_barrier_complete(unsigned* bar, unsigned x, unsigned& nloc, unsigned& nx) {
    const unsigned G = gridDim.x * gridDim.y * gridDim.z;
    unsigned sum, cnt, mine, sp = 0u;
    for (;;) {
        sum = 0u; cnt = 0u; mine = 0u;
#pragma unroll
        for (unsigned j = 0; j < 16; ++j) { const unsigned c = xb_ld(&bar[XB_XCNT(j)]); sum += c; cnt += (c > 0u) ? 1u : 0u; mine = (j == x) ? c : mine; }
        if (sum == G) break;
        __builtin_amdgcn_s_sleep(1);
        if ((++sp & 255u) == 0u) { if (xb_ld(&bar[XB_TMO])) break; if (sp > XB_SPIN_CAP) { atomicAdd(&bar[XB_TMO], 1u); break; } }
    }
    nloc = mine > 0u ? mine : 1u; nx = cnt > 0u ? cnt : 1u;
}

__device__ __forceinline__ void xcd_barrier(const XcdBarrier& b) {
    asm volatile("s_waitcnt vmcnt(0)" ::: "memory");
    __syncthreads();
    if (threadIdx.x == 0) {
        unsigned* bar = b.bar;
        __builtin_amdgcn_s_waitcnt(0);
        unsigned nloc = b.st[0], nx = b.st[1];
        if (nloc == 0u) { xcd_barrier_complete(bar, b.x, nloc, nx); b.st[0] = nloc; b.st[1] = nx; }
        const unsigned old = xb_add(&bar[XB_XSUB(b.x)], 1u);
        const unsigned gen = old / nloc;
        if (old + 1u == (gen + 1u) * nloc) {
            __builtin_amdgcn_fence(__ATOMIC_RELEASE, "agent");
            asm volatile("s_waitcnt vmcnt(0)" ::: "memory");
            const unsigned og = xb_add(&bar[XB_TOP], 1u);
            const unsigned tg = og / nx;
            if (og + 1u == (tg + 1u) * nx) xb_add(&bar[XB_TOPGEN], 1u);
            else XB_SPIN(xb_ld(&bar[XB_TOPGEN]) == tg, bar);
            __builtin_amdgcn_fence(__ATOMIC_ACQUIRE, "agent");
            xb_add(&bar[XB_XGEN(b.x)], 1u);
            asm volatile("s_waitcnt vmcnt(0)" ::: "memory");
        } else {
            XB_SPIN(xb_ld(&bar[XB_XGEN(b.x)]) == gen, bar);
            __builtin_amdgcn_fence(__ATOMIC_ACQUIRE, "agent");
            asm volatile("s_waitcnt vmcnt(0)" ::: "memory");
        }
    }
    __syncthreads();
}

__device__ __forceinline__ void tr_item(const float* W, int ldw, bf16* WT, int ldwt, int k0, int n0, int drow0, const float* ksc, LAS float* scr, int lane) {
#pragma unroll 8
    for (int i = 0; i < 32; ++i) { const int kk = 2 * i + (lane >> 5); float v = W[(size_t)(k0 + kk) * ldw + n0 + (lane & 31)]; if (ksc) v *= ksc[k0 + kk]; scr[kk * 33 + (lane & 31)] = v; }
    LDS_WAIT(); asm volatile("" ::: "memory");
    const int c = lane & 7;
#pragma unroll
    for (int j = 0; j < 4; ++j) { const int n = (lane >> 3) + 8 * j; const LAS float* s = scr + (8 * c) * 33 + n;
        v4u o; o.x = pk2(s[0 * 33], s[1 * 33]); o.y = pk2(s[2 * 33], s[3 * 33]); o.z = pk2(s[4 * 33], s[5 * 33]); o.w = pk2(s[6 * 33], s[7 * 33]);
        *(GAS v4u*)(WT + (size_t)(drow0 + n) * ldwt + k0 + 8 * c) = o; }
    LDS_WAIT(); asm volatile("" ::: "memory");
}

struct Ptrs {
    const float *x, *p, *g_mix, *w_in, *conv_w, *conv_b, *ln_g, *ln_b, *pool_w, *pool_scale, *w_out, *g_ffn, *w_gu, *w_down, *g_pg, *w_pg, *w_pu, *g_post, *g_final;
    float* out; unsigned char* ws;
};

__device__ __forceinline__ void p0_prologue(const Ptrs& P, LAS unsigned char* lds, int vcu, int G) {
    const int lane = threadIdx.x & 63, wave = __builtin_amdgcn_readfirstlane(threadIdx.x >> 6);
    LAS float* scr = (LAS float*)(lds + wave * 16384);
    const int gw = vcu * NWAVES + wave, NGW = G * NWAVES;
    bf16* WinT = (bf16*)(P.ws + WS_WIN); bf16* WoutT = (bf16*)(P.ws + WS_WOUT); bf16* WguT = (bf16*)(P.ws + WS_WGU); bf16* WdT = (bf16*)(P.ws + WS_WD);
    bf16* WpgT = (bf16*)(P.ws + WS_WPG); bf16* WpuT = (bf16*)(P.ws + WS_WPU);
    constexpr int I_IN = 16 * 48, I_OUT = 8 * 32, I_GU = 16 * 176, I_D = 44 * 32, I_PG = 16 * 32, I_PU = 4 * 32, I_FOLD = 1024;
    constexpr int NITEMS = I_IN + I_OUT + I_GU + I_D + I_PG + I_PU + I_FOLD;
    for (int it = gw; it < NITEMS; it += NGW) {
        int r = it;
        if (r < I_IN) { const int kb = r / 48, n0 = 32 * (r % 48); const int dr = n0 < 1024 ? (((n0 & 511) >> 7) * 256 + (n0 >> 9) * 128 + (n0 & 127)) : n0;
            tr_item(P.w_in, NIN, WinT, D, 64 * kb, n0, dr, P.g_mix, scr, lane); continue; } r -= I_IN;
        if (r < I_OUT) { tr_item(P.w_out, D, WoutT, D, 64 * (r / 32), 32 * (r % 32), 32 * (r % 32), nullptr, scr, lane); continue; } r -= I_OUT;
        if (r < I_GU) { const int kb = r / 176, n0 = 32 * (r % 176), hf = n0 >= FF ? 1 : 0, rem = n0 - hf * FF; const int dr = (rem >> 7) * 256 + hf * 128 + (rem & 127);
            tr_item(P.w_gu, 2 * FF, WguT, D, 64 * kb, n0, dr, P.g_ffn, scr, lane); continue; } r -= I_GU;
        if (r < I_D) { tr_item(P.w_down, D, WdT, FF, 64 * (r / 32), 32 * (r % 32), 32 * (r % 32), nullptr, scr, lane); continue; } r -= I_D;
        if (r < I_PG) { tr_item(P.w_pg, D, WpgT, D, 64 * (r / 32), 32 * (r % 32), 32 * (r % 32), P.g_pg, scr, lane); continue; } r -= I_PG;
        if (r < I_PU) { tr_item(P.w_pu, D, WpuT, DPLE, 64 * (r / 32), 32 * (r % 32), 32 * (r % 32), nullptr, scr, lane); continue; } r -= I_PU;
        {
            const int g = r >> 8, c0 = 8 * ((r >> 4) & 15), n0 = 64 * (r & 15);
            const float* pw = P.pool_w + (size_t)(g * 128 + c0) * 128;
            float a[8];
#pragma unroll
            for (int c = 0; c < 8; ++c) a[c] = 0.f;
            for (int d = 0; d < 128; ++d) { const float wv = P.w_out[(size_t)(512 + g * 128 + d) * D + n0 + lane] * P.pool_scale[g * 128 + d];
#pragma unroll
                for (int c = 0; c < 8; ++c) a[c] += pw[c * 128 + d] * wv; }
            v4u o; o.x = pk2(a[0], a[1]); o.y = pk2(a[2], a[3]); o.z = pk2(a[4], a[5]); o.w = pk2(a[6], a[7]);
            *(GAS v4u*)(WoutT + (size_t)(n0 + lane) * D + 512 + g * 128 + c0) = o;
        }
    }
    bf16* XN = (bf16*)(P.ws + WS_XB);
    for (int m = gw; m < M; m += NGW) {
        const GAS f32x4* xr = (const GAS f32x4*)(P.x + (size_t)m * D) + lane;
        f32x4 v[4]; float s = 0.f;
#pragma unroll
        for (int j = 0; j < 4; ++j) { v[j] = xr[64 * j]; s += (v[j].x * v[j].x + v[j].y * v[j].y) + (v[j].z * v[j].z + v[j].w * v[j].w); }
        const float rstd = rsqrtf(wave_sum(s) * (1.f / D) + EPS);
        GAS v2u* o8 = (GAS v2u*)(XN + (size_t)m * D) + lane;
#pragma unroll
        for (int j = 0; j < 4; ++j) { v2u w; w.x = pk2(v[j].x * rstd, v[j].y * rstd); w.y = pk2(v[j].z * rstd, v[j].w * rstd); o8[64 * j] = w; }
    }
    bf16* PB = (bf16*)(P.ws + WS_PB);
    for (int m = gw; m < M; m += NGW) {
        const f32x4 v = *((const GAS f32x4*)(P.p + (size_t)m * DPLE) + lane);
        v2u w; w.x = pk2(v.x, v.y); w.y = pk2(v.z, v.w); *((GAS v2u*)(PB + (size_t)m * DPLE) + lane) = w;
    }
}

__device__ __forceinline__ void p2_mixer(const Ptrs& P, LAS unsigned char* lds, int G, int nrep) {
    const int tid = threadIdx.x, half = __builtin_amdgcn_readfirstlane(tid >> 8), cp = tid & 255, lane = tid & 63;
    const int pg = __builtin_amdgcn_readfirstlane(tid >> 6) & 3;
    LAS float* red = (LAS float*)lds;
    LAS float* tot = (LAS float*)(lds + 65536);
    const GAS unsigned* UV32 = (const GAS unsigned*)(P.ws + WS_UV); GAS unsigned* MIX32 = (GAS unsigned*)(P.ws + WS_MIX);
    f32x2 w[CONVK];
#pragma unroll
    for (int k = 0; k < CONVK; ++k) w[k] = *(const f32x2*)(P.conv_w + k * CCONV + 2 * cp);
    const f32x2 cb = *(const f32x2*)(P.conv_b + 2 * cp), lg = *(const f32x2*)(P.ln_g + 2 * cp), lb = *(const f32x2*)(P.ln_b + 2 * cp);
    for (int uu = blockIdx.x; uu < nrep * (M / 32); uu += G) { const int unit = uu % (M / 32);
        const int m0 = unit * 32 + half * 16, t0 = m0 & (SEQ - 1);
        unsigned uin[46], vin[31];
#pragma unroll
        for (int j = 0; j < 46; ++j) { const int dt = j - 30; const bool ok = (t0 + dt) >= 0; const unsigned v = UV32[(size_t)(ok ? m0 + dt : m0) * 512 + cp]; uin[j] = ok ? v : 0u; }
#pragma unroll
        for (int j = 0; j < 31; ++j) { const int dt = j - 15; const bool ok = (t0 + dt) >= 0; const unsigned v = UV32[(size_t)(ok ? m0 + dt : m0) * 512 + 256 + cp]; vin[j] = ok ? v : 0u; }
        f32x2 acc[16];
#pragma unroll
        for (int i = 0; i < 16; ++i) acc[i] = cb;
#pragma unroll
        for (int j = 0; j < 46; ++j) {
            const f32x2 uv = (f32x2){pg8::bf_lo(uin[j]), pg8::bf_hi(uin[j])};
#pragma unroll
            for (int i = 0; i < 16; ++i) { const int k = j - i; if (k >= 0 && k < CONVK) acc[i] += w[k] * uv; }
        }
#pragma unroll
        for (int i = 0; i < 16; ++i) { red[(half * 32 + i) * 256 + cp] = acc[i].x + acc[i].y; red[(half * 32 + 16 + i) * 256 + cp] = acc[i].x * acc[i].x + acc[i].y * acc[i].y; }
        LDS_WAIT(); __builtin_amdgcn_s_barrier(); asm volatile("" ::: "memory");
        { const int v = cp >> 3, s = cp & 7; float sum = 0.f;
#pragma unroll
            for (int j = 0; j < 32; ++j) sum += red[(half * 32 + v) * 256 + s * 32 + ((j + lane) & 31)];
            sum += __shfl_xor(sum, 1); sum += __shfl_xor(sum, 2); sum += __shfl_xor(sum, 4);
            if (s == 0) tot[half * 32 + v] = sum; }
        LDS_WAIT(); __builtin_amdgcn_s_barrier(); asm volatile("" ::: "memory");
        float st[32];
#pragma unroll
        for (int q = 0; q < 8; ++q) { const f32x4 t4 = *(const LAS f32x4*)(tot + half * 32 + 4 * q); st[4 * q] = t4.x; st[4 * q + 1] = t4.y; st[4 * q + 2] = t4.z; st[4 * q + 3] = t4.w; }
#pragma unroll
        for (int i = 0; i < 16; ++i) {
            const float mean = st[i] * (1.f / CCONV), var = st[16 + i] * (1.f / CCONV) - mean * mean, rstd = rsqrtf(var + EPS);
            const float y0 = (acc[i].x - mean) * rstd * lg.x + lb.x, y1 = (acc[i].y - mean) * rstd * lg.y + lb.y;
            MIX32[(size_t)(m0 + i) * 512 + cp] = pk2(y0 * pg8::sigm(y0), y1 * pg8::sigm(y1));
        }
        f32x2 sv[31], og[16];
#pragma unroll
        for (int j = 0; j < 31; ++j) sv[j] = (f32x2){pg8::bf_lo(vin[j]), pg8::bf_hi(vin[j])};
#pragma unroll
        for (int i = 0; i < 16; ++i) og[i] = sv[15 + i];
#pragma unroll
        for (int j = 30; j >= 1; --j) sv[j] += sv[j - 1];
        if (pg >= 1) {
#pragma unroll
            for (int j = 30; j >= 3; --j) sv[j] += sv[j - 2]; }
        if (pg >= 2) {
#pragma unroll
            for (int j = 30; j >= 7; --j) sv[j] += sv[j - 4]; }
        if (pg >= 3) {
#pragma unroll
            for (int j = 30; j >= 15; --j) sv[j] += sv[j - 8]; }
        const int wnd = 2 << pg;
#pragma unroll
        for (int i = 0; i < 16; ++i) { const int cnt = (t0 + i + 1) < wnd ? (t0 + i + 1) : wnd; const float inv = 1.0f / (float)cnt;
            MIX32[(size_t)(m0 + i) * 512 + 256 + cp] = pk2(sv[15 + i].x * inv - og[i].x, sv[15 + i].y * inv - og[i].y); }
    }
}

__device__ __forceinline__ void p8_final(const Ptrs& P, const float* X3, int vcu, int G) {
    const int lane = threadIdx.x & 63, wave = __builtin_amdgcn_readfirstlane(threadIdx.x >> 6);
    const int gw = vcu * NWAVES + wave, NGW = G * NWAVES;
    f32x4 gf[4];
#pragma unroll
    for (int j = 0; j < 4; ++j) gf[j] = *((const GAS f32x4*)P.g_final + lane + 64 * j);
    for (int m = gw; m < M; m += NGW) {
        const GAS f32x4* xi = (const GAS f32x4*)(X3 + (size_t)m * D) + lane; GAS f32x4* xr = (GAS f32x4*)(P.out + (size_t)m * D) + lane;
        f32x4 v[4]; float s = 0.f;
#pragma unroll
        for (int j = 0; j < 4; ++j) { v[j] = xi[64 * j]; s += (v[j].x * v[j].x + v[j].y * v[j].y) + (v[j].z * v[j].z + v[j].w * v[j].w); }
        const float rstd = rsqrtf(wave_sum(s) * (1.f / D) + EPS);
#pragma unroll
        for (int j = 0; j < 4; ++j) xr[64 * j] = v[j] * rstd * gf[j];
    }
}

struct Args { const float* in[19]; float* out; unsigned char* ws; int ph_lo, ph_hi; };
static_assert(sizeof(Args) == 19 * 8 + 8 + 8 + 8, "Args has no padding");

__global__ void __launch_bounds__(NWAVES * 64, 2) fwd_megakernel(Args args) {
    extern __shared__ __attribute__((aligned(16))) unsigned char lds_raw[];
    LAS unsigned char* lds = (LAS unsigned char*)lds_raw;
    const int G = gridDim.x, bx = blockIdx.x, vcu = (G % 8 == 0) ? (bx % 8) * (G / 8) + bx / 8 : bx;
    Ptrs P;
    P.x = args.in[0]; P.p = args.in[1]; P.g_mix = args.in[2]; P.w_in = args.in[3]; P.conv_w = args.in[4]; P.conv_b = args.in[5]; P.ln_g = args.in[6]; P.ln_b = args.in[7];
    P.pool_w = args.in[8]; P.pool_scale = args.in[9]; P.w_out = args.in[10]; P.g_ffn = args.in[11]; P.w_gu = args.in[12]; P.w_down = args.in[13]; P.g_pg = args.in[14];
    P.w_pg = args.in[15]; P.w_pu = args.in[16]; P.g_post = args.in[17]; P.g_final = args.in[18]; P.out = args.out; P.ws = args.ws;
    unsigned char* ws = args.ws;
    pg8::bf16_t* WinT = (pg8::bf16_t*)(ws + WS_WIN); pg8::bf16_t* WoutT = (pg8::bf16_t*)(ws + WS_WOUT); pg8::bf16_t* WguT = (pg8::bf16_t*)(ws + WS_WGU); pg8::bf16_t* WdT = (pg8::bf16_t*)(ws + WS_WD);
    pg8::bf16_t* WpgT = (pg8::bf16_t*)(ws + WS_WPG); pg8::bf16_t* WpuT = (pg8::bf16_t*)(ws + WS_WPU);
    pg8::bf16_t* XB = (pg8::bf16_t*)(ws + WS_XB); pg8::bf16_t* PB = (pg8::bf16_t*)(ws + WS_PB); pg8::bf16_t* UV = (pg8::bf16_t*)(ws + WS_UV); pg8::bf16_t* MIX = (pg8::bf16_t*)(ws + WS_MIX);
    pg8::bf16_t* ACT = (pg8::bf16_t*)(ws + WS_ACT); pg8::bf16_t* ERAW = (pg8::bf16_t*)(ws + WS_ERAW);
    float* X1 = (float*)(ws + WS_X1); float* SSQ2 = (float*)(ws + WS_SSQ2); float* SSQ3 = (float*)(ws + WS_SSQ3); float* SSQE = (float*)(ws + WS_SSQE);

    const int lo = args.ph_lo, hi = args.ph_hi;
    if (threadIdx.x < 2) ((volatile LAS unsigned*)(lds + MISC_OFF))[threadIdx.x] = 0u;
    __syncthreads();
    XcdBarrier bar; bar.bar = (unsigned*)(ws + WS_CTL); bar.x = 0; bar.st = nullptr;
    if (hi - lo > 1) bar = xcd_barrier_post((unsigned*)(ws + WS_CTL), (volatile LAS unsigned*)(lds + MISC_OFF));
#define IN(k) (lo <= (k) && (k) < hi)
#ifndef DUP_MASK
#define DUP_MASK 0
#endif
#define NREP(k) (((DUP_MASK >> (k)) & 1) ? 2 : 1)
#define SEAM(k) do { if (IN(k) && IN((k) + 1)) { xcd_barrier(bar); if (NREP(9) == 2) xcd_barrier(bar); } } while (0)

    if (IN(0)) { p0_prologue(P, lds, vcu, G); __syncthreads(); if (NREP(0) == 2) { p0_prologue(P, lds, vcu, G); __syncthreads(); } }
    SEAM(0);
    if (IN(1)) { pg8::Gemm g{XB, WinT, M, NIN, D}; pg8::StaticOrder S; S.init(M, NIN, G, bx, NREP(1)); pg8::EpiGlu E{UV};
        pg8::gemm_phase<pg8::EpiGlu, pg8::StaticOrder, PG8_ALIGN, PG8_SP2>(lds, g, S, E); }
    SEAM(1);
    if (IN(2)) { p2_mixer(P, lds, G, NREP(2)); __syncthreads(); }
    SEAM(2);
    if (IN(3)) { pg8::Gemm g{MIX, WoutT, M, D, D}; pg8::StaticOrder S; S.init(M, D, G, bx, NREP(3)); pg8::EpiRes E{P.x, X1, XB, SSQ2};
        pg8::gemm_phase<pg8::EpiRes, pg8::StaticOrder, PG8_ALIGN, PG8_SP2>(lds, g, S, E); }
    SEAM(3);
    if (IN(4)) { pg8::Gemm g{XB, WguT, M, 2 * FF, D}; pg8::StaticOrder S; S.init(M, 2 * FF, G, bx, NREP(4)); pg8::EpiSwiglu E{ACT, FF, SSQ2};
        pg8::gemm_phase<pg8::EpiSwiglu, pg8::StaticOrder, PG8_ALIGN, PG8_SP2>(lds, g, S, E); }
    SEAM(4);
    if (IN(5)) { pg8::Gemm g{ACT, WdT, M, D, FF}; pg8::StaticOrder S; S.init(M, D, G, bx, NREP(5)); pg8::EpiRes E{X1, P.out, XB, SSQ3};
        pg8::gemm_phase<pg8::EpiRes, pg8::StaticOrder, PG8_ALIGN, PG8_SP2>(lds, g, S, E); }
    if (IN(6)) { pg8::Gemm g{PB, WpuT, M, D, DPLE}; pg8::StaticOrder S; S.init(M, D, G, bx, NREP(6)); pg8::EpiRaw E{ERAW, SSQE};
        pg8::gemm_phase<pg8::EpiRaw, pg8::StaticOrder, PG8_ALIGN, PG8_SP2>(lds, g, S, E); }
    SEAM(6);
    if (IN(7)) { pg8::Gemm g{XB, WpgT, M, D, D}; pg8::StaticOrder S; S.init(M, D, G, bx, NREP(7)); pg8::EpiPle E{P.out, X1, ERAW, SSQ3, SSQE, P.g_post};
        pg8::gemm_phase<pg8::EpiPle, pg8::StaticOrder, PG8_ALIGN, PG8_SP2>(lds, g, S, E); }
    SEAM(7);
    if (IN(8)) { p8_final(P, X1, vcu, G); if (NREP(8) == 2) p8_final(P, X1, vcu, G); }
#undef IN
#undef SEAM
}

extern "C" void kernel_launch(void* const* d_in, const int* in_sizes, int n_in, void* d_out, int out_size, void* d_ws, size_t ws_size, hipStream_t stream) {
    static int grid = 0;
    if (grid == 0) {
        if (n_in != 19 || in_sizes[0] != M * D || out_size != M * D || ws_size < WS_END) { fprintf(stderr, "kernel_launch: unexpected shapes (n_in %d, in0 %d, out %d, ws %zu); nothing launched\n", n_in, n_in > 0 ? in_sizes[0] : -1, out_size, ws_size); grid = -1; return; }
        int dev = 0, cus = 0, per_cu = 0;
        if (hipGetDevice(&dev) != hipSuccess || hipDeviceGetAttribute(&cus, hipDeviceAttributeMultiprocessorCount, dev) != hipSuccess) { grid = -1; return; }
        if (hipFuncSetAttribute((const void*)fwd_megakernel, hipFuncAttributeMaxDynamicSharedMemorySize, LDS_BYTES) != hipSuccess) { fprintf(stderr, "kernel_launch: hipFuncSetAttribute failed\n"); grid = -1; return; }
        if (hipOccupancyMaxActiveBlocksPerMultiprocessor(&per_cu, (const void*)fwd_megakernel, NWAVES * 64, LDS_BYTES) != hipSuccess || per_cu < 1) { fprintf(stderr, "kernel_launch: occupancy query says %d blocks per CU; nothing launched\n", per_cu); (void)hipGetLastError(); grid = -1; return; }
        grid = cus;
    }
    if (grid < 0) return;
    Args a{};
    for (int i = 0; i < 19; ++i) a.in[i] = (const float*)d_in[i];
    a.out = (float*)d_out; a.ws = (unsigned char*)d_ws;
    if (N_LAUNCHES == 1) {
        a.ph_lo = 0; a.ph_hi = N_PHASES;
        if (hipMemsetAsync((char*)d_ws + WS_CTL, 0, CTL_ZERO_BYTES, stream) != hipSuccess) { fprintf(stderr, "kernel_launch: hipMemsetAsync failed\n"); return; }
        hipLaunchKernelGGL(fwd_megakernel, dim3(grid), dim3(NWAVES * 64), LDS_BYTES, stream, a);
    } else {
        for (int li = 0; li < N_PHASES; ++li) { a.ph_lo = li; a.ph_hi = li + 1; hipLaunchKernelGGL(fwd_megakernel, dim3(grid), dim3(NWAVES * 64), LDS_BYTES, stream, a); }
    }
}
```
